# Optimizing an MI355X kernel written in HIP

```python
import math
import jax, jax.numpy as jnp
from jax import lax
import numpy as np

D_MODEL = 1024
BATCH = 8
SEQ = 4096
DEPTH = 2

GRID_W = 64
CTX_LEN = 256
EPS = 1e-6

SG_WIDTH = 1024
SG_CHUNK = 128
SG_GROUPS = 8
SG_GROUP_DIM = SG_WIDTH // SG_GROUPS

DN_HEADS = 8
DN_DIM = 128
DN_WIDTH = DN_HEADS * DN_DIM
DN_CONV = 5
DN_CHUNK = 64

AT_Q_HEADS = 16
AT_KV_HEADS = 2
AT_DIM = 64
AT_Q_WIDTH = AT_Q_HEADS * AT_DIM
AT_KV_WIDTH = AT_KV_HEADS * AT_DIM
AT_WINDOW = 128
AT_BLOCK = 128
ROPE_BASE = 10000.0

N_EXPERTS = 32
TOP_K = 4
D_EXPERT = 1024
SWIGLU_ALPHA = 1.702
SWIGLU_LIMIT = 7.0
MOE_BLOCK = 128

N_BRANCH = 3

IN_COLS = (("dn_k", DN_WIDTH), ("dn_v", DN_WIDTH), ("dn_a", 2 * DN_HEADS), ("dn_b", 2 * DN_HEADS),
           ("at_k", AT_KV_WIDTH), ("at_v", AT_KV_WIDTH),
           ("dn_q", DN_WIDTH), ("dn_g", DN_WIDTH), ("at_q", AT_Q_WIDTH),
           ("sg_u", SG_WIDTH), ("sg_v", SG_WIDTH), ("gates", N_BRANCH * D_MODEL))
N_CTX_COLS = 2 * DN_WIDTH + 4 * DN_HEADS + 2 * AT_KV_WIDTH
D_IN = N_CTX_COLS + 2 * DN_WIDTH + AT_Q_WIDTH + 2 * SG_WIDTH + N_BRANCH * D_MODEL

kernel_name = "hybrid_gated_parallel_mixer_moe_dit"

F32 = jnp.float32


def _rms_norm(x, g):
    xf = x.astype(F32)
    y = xf * lax.rsqrt(jnp.mean(xf * xf, axis=-1, keepdims=True) + EPS)
    return (y * g.astype(F32)).astype(x.dtype)


def _layer_norm(x, g, b):
    xf = x.astype(F32)
    xc = xf - jnp.mean(xf, axis=-1, keepdims=True)
    var = jnp.mean(xc * xc, axis=-1, keepdims=True)
    return (xc * lax.rsqrt(var + EPS) * g.astype(F32) + b.astype(F32)).astype(x.dtype)


def _l2_norm(x):
    xf = x.astype(F32)
    return (xf * lax.rsqrt(jnp.sum(xf * xf, axis=-1, keepdims=True) + EPS)).astype(x.dtype)


def _split_cols(p):
    out, off = {}, 0
    for name, width in IN_COLS:
        if off + width > p.shape[-1]:
            break
        out[name] = p[..., off:off + width]
        off += width
    return out


def _short_conv(x, w):
    K, T, pad = w.shape[0], x.shape[1], w.shape[0] // 2
    xp = jnp.pad(x, ((0, 0), (pad, pad), (0, 0)))
    y = xp[:, 0:T] * w[0]
    for i in range(1, K):
        y = y + xp[:, i:i + T] * w[i]
    return y


def _axial_rope(x, row, col):
    half = AT_DIM // 2
    nf = half // 2
    inv_freq = ROPE_BASE ** (-jnp.arange(nf, dtype=F32) / nf)
    xf = x.astype(F32)

    def rotate(xs, pos):
        ang = pos.astype(F32)[:, None] * inv_freq
        cos, sin = jnp.cos(ang)[None, :, None, :], jnp.sin(ang)[None, :, None, :]
        x1, x2 = xs[..., :nf], xs[..., nf:]
        return jnp.concatenate([x1 * cos - x2 * sin, x2 * cos + x1 * sin], axis=-1)

    return jnp.concatenate([rotate(xf[..., :half], row), rotate(xf[..., half:], col)], axis=-1).astype(x.dtype)


def _softmax_with_sink(logits, sink):
    sink_col = jnp.broadcast_to(sink[None, :, :, None, None], logits.shape[:-1] + (1,))
    return jax.nn.softmax(jnp.concatenate([logits, sink_col], axis=-1), axis=-1)[..., :-1]


def _sgu_branch(cols, ln_g, ln_b, w_s, b_s):
    u = jax.nn.gelu(cols["sg_u"])
    v = _layer_norm(jax.nn.gelu(cols["sg_v"]), ln_g, ln_b)
    B, T, _ = v.shape
    vb = v.reshape(B, T // SG_CHUNK, SG_CHUNK, SG_GROUPS, SG_GROUP_DIM)
    mixed = jnp.einsum("gpq,bnqgc->bnpgc", w_s, vb) + b_s.T[:, :, None]
    return u * mixed.reshape(B, T, SG_WIDTH)


def _gated_delta_chunked(q, k, v, log_decay, beta, s0, with_output):
    B, T, H, dk = k.shape
    dv = v.shape[-1]
    C = DN_CHUNK
    n = T // C

    def chunks(t):
        t = t.astype(F32).reshape((B, n, C, H) + t.shape[3:])
        return jnp.moveaxis(jnp.swapaxes(t, 2, 3), 1, 0)

    kc, vc, bc = chunks(k), chunks(v), chunks(beta)
    gam = jnp.cumsum(chunks(log_decay), axis=-1)
    idx = jnp.arange(C)
    incl = idx[:, None] >= idx[None, :]
    decay = jnp.exp(jnp.where(incl, gam[..., :, None] - gam[..., None, :], -jnp.inf))
    a_mat = (jnp.where(idx[:, None] > idx[None, :], decay, 0.0) * bc[..., :, None]
             * jnp.einsum("nbhid,nbhjd->nbhij", kc, kc))
    rhs = jnp.concatenate([kc * (bc * jnp.exp(gam))[..., None], vc * bc[..., None]], axis=-1)
    sol = lax.linalg.triangular_solve(a_mat + jnp.eye(C, dtype=F32), rhs,
                                      left_side=True, lower=True, unit_diagonal=True)
    w, u0 = sol[..., :dk], sol[..., dk:]
    k_end = kc * jnp.exp(gam[..., -1:] - gam)[..., None]
    chunk_decay = jnp.exp(gam[..., -1])[..., None, None]
    if with_output:
        qc = chunks(q)
        qk = jnp.einsum("nbhid,nbhjd->nbhij", qc, kc) * decay
        q_start = qc * jnp.exp(gam)[..., None]
        xs = (w, u0, k_end, chunk_decay, qk, q_start)
    else:
        xs = (w, u0, k_end, chunk_decay)

    def step(s, blk):
        u = blk[1] - jnp.einsum("bhcd,bhde->bhce", blk[0], s)
        s_new = blk[3] * s + jnp.einsum("bhcd,bhce->bhde", blk[2], u)
        if not with_output:
            return s_new, None
        o = jnp.einsum("bhcd,bhde->bhce", blk[5], s) + jnp.einsum("bhij,bhje->bhie", blk[4], u)
        return s_new, o

    s_fin, o = lax.scan(step, s0, xs)
    if with_output:
        o = jnp.swapaxes(jnp.moveaxis(o, 0, 1), 2, 3).reshape(B, T, H, dv).astype(v.dtype)
    return o, s_fin


def _dn_inputs(cols, conv_w, a_log, dt_bias, with_q):
    B, T, _ = cols["dn_k"].shape

    def conv_heads(name, part):
        y = jax.nn.silu(_short_conv(cols[name], conv_w[:, part * DN_WIDTH:(part + 1) * DN_WIDTH]))
        return y.reshape(B, T, DN_HEADS, DN_DIM)

    k = _l2_norm(conv_heads("dn_k", 1))
    v = conv_heads("dn_v", 2)
    a = cols["dn_a"].reshape(B, T, 2, DN_HEADS).astype(F32)
    log_decay = -jnp.exp(a_log.astype(F32)) * jax.nn.softplus(a + dt_bias.astype(F32))
    beta = jax.nn.sigmoid(cols["dn_b"].reshape(B, T, 2, DN_HEADS).astype(F32))
    q = _l2_norm(conv_heads("dn_q", 0)) * DN_DIM ** -0.5 if with_q else None
    return q, k, v, log_decay, beta


def _flip(t):
    return None if t is None else jnp.flip(t, axis=1)


def _ident(t):
    return t


def _deltanet_branch(cols, cols_c, conv_w, a_log, dt_bias, norm_g, need_ctx_out):
    q, k, v, la, be = _dn_inputs(cols, conv_w, a_log, dt_bias, True)
    qc, kc, vc, lac, bec = _dn_inputs(cols_c, conv_w, a_log, dt_bias, need_ctx_out)
    B, T = k.shape[0], k.shape[1]
    s0 = jnp.zeros((B, DN_HEADS, DN_DIM, DN_DIM), F32)
    o_lat, o_ctx = None, None
    for d in range(2):
        tr = _ident if d == 0 else _flip
        oc, sc = _gated_delta_chunked(tr(qc), tr(kc), tr(vc), tr(lac[:, :, d]), tr(bec[:, :, d]), s0, need_ctx_out)
        ol, _ = _gated_delta_chunked(tr(q), tr(k), tr(v), tr(la[:, :, d]), tr(be[:, :, d]), sc, True)
        o_lat = tr(ol) if o_lat is None else o_lat + tr(ol)
        if need_ctx_out:
            o_ctx = tr(oc) if o_ctx is None else o_ctx + tr(oc)

    def finish(o, c):
        Bt, Tt = o.shape[0], o.shape[1]
        g = jax.nn.silu(c["dn_g"].reshape(Bt, Tt, DN_HEADS, DN_DIM))
        return (_rms_norm(o, norm_g) * g).reshape(Bt, Tt, DN_WIDTH)

    return finish(o_lat, cols), (finish(o_ctx, cols_c) if need_ctx_out else None)


def _window_attention(q, k, v, kc, vc, sink):
    B, S, Hkv, G, dh = q.shape
    P, W = AT_BLOCK, AT_WINDOW
    nb = S // P
    span = P + 2 * W
    qb = jnp.moveaxis(q.reshape(B, nb, P, Hkv, G, dh), 1, 0)
    key_idx = jnp.arange(nb)[:, None] * P + jnp.arange(span)[None, :]
    pad = ((0, 0), (W, W), (0, 0), (0, 0))
    kb = jnp.moveaxis(jnp.pad(k, pad)[:, key_idx], 1, 0)
    vb = jnp.moveaxis(jnp.pad(v, pad)[:, key_idx], 1, 0)
    q_pos = jnp.arange(nb)[:, None] * P + jnp.arange(P)[None, :]
    k_pos = key_idx - W
    mask = ((jnp.abs(k_pos[:, None, :] - q_pos[:, :, None]) <= W)
            & (k_pos[:, None, :] >= 0) & (k_pos[:, None, :] < S))

    def one_block(blk):
        qn, kn, vn, mn = blk
        s_loc = jnp.where(mn[None, None, None], jnp.einsum("bqhgd,bkhd->bhgqk", qn, kn).astype(F32), -jnp.inf)
        s_ctx = jnp.einsum("bqhgd,bkhd->bhgqk", qn, kc).astype(F32)
        pr = _softmax_with_sink(jnp.concatenate([s_loc, s_ctx], axis=-1), sink).astype(vn.dtype)
        return (jnp.einsum("bhgqk,bkhd->bqhgd", pr[..., :span], vn)
                + jnp.einsum("bhgqk,bkhd->bqhgd", pr[..., span:], vc))

    out = lax.map(one_block, (qb, kb, vb, mask))
    return jnp.moveaxis(out, 0, 1).reshape(B, S, Hkv * G * dh)


def _attention_branch(cols, cols_c, sinks, row, col, need_ctx_out):
    B, S, _ = cols["at_k"].shape
    L = cols_c["at_k"].shape[1]
    G = AT_Q_HEADS // AT_KV_HEADS
    scale = AT_DIM ** -0.5
    q = _axial_rope(cols["at_q"].reshape(B, S, AT_Q_HEADS, AT_DIM), row, col) * scale
    k = _axial_rope(cols["at_k"].reshape(B, S, AT_KV_HEADS, AT_DIM), row, col)
    v = cols["at_v"].reshape(B, S, AT_KV_HEADS, AT_DIM)
    kc = cols_c["at_k"].reshape(B, L, AT_KV_HEADS, AT_DIM)
    vc = cols_c["at_v"].reshape(B, L, AT_KV_HEADS, AT_DIM)
    sink = sinks.astype(F32).reshape(AT_KV_HEADS, G)
    y = _window_attention(q.reshape(B, S, AT_KV_HEADS, G, AT_DIM), k, v, kc, vc, sink)
    y_c = None
    if need_ctx_out:
        qc = cols_c["at_q"].reshape(B, L, AT_KV_HEADS, G, AT_DIM) * scale
        pr = _softmax_with_sink(jnp.einsum("bqhgd,bkhd->bhgqk", qc, kc).astype(F32), sink)
        y_c = jnp.einsum("bhgqk,bkhd->bqhgd", pr.astype(vc.dtype), vc).reshape(B, L, AT_Q_WIDTH)
    return y, y_c


def _merge(gate_cols, y_sg, y_dn, y_at, lp):
    g = jax.nn.sigmoid(gate_cols.reshape(gate_cols.shape[:-1] + (N_BRANCH, D_MODEL)))
    m = (g[..., 0, :] * (y_sg @ lp["w_proj_sg"]) + g[..., 1, :] * (y_dn @ lp["w_proj_dn"])
         + g[..., 2, :] * (y_at @ lp["w_proj_at"]))
    return m @ lp["w_out"]


def _mixer(h, hc, lp, row, col, need_ctx_out):
    cols = _split_cols(h @ lp["w_in"])
    cols_c = _split_cols(hc @ (lp["w_in"] if need_ctx_out else lp["w_in"][:, :N_CTX_COLS]))
    y_dn, y_dn_c = _deltanet_branch(cols, cols_c, lp["dn_conv_w"], lp["dn_a_log"], lp["dn_dt_bias"],
                                    lp["dn_norm_g"], need_ctx_out)
    y_at, y_at_c = _attention_branch(cols, cols_c, lp["at_sinks"], row, col, need_ctx_out)
    y_sg = _sgu_branch(cols, lp["sg_ln_g"], lp["sg_ln_b"], lp["sg_w"], lp["sg_b"])
    out = _merge(cols["gates"], y_sg, y_dn, y_at, lp)
    out_c = None
    if need_ctx_out:
        y_sg_c = _sgu_branch(cols_c, lp["sg_ln_g"], lp["sg_ln_b"], lp["sg_w"], lp["sg_b"])
        out_c = _merge(cols_c["gates"], y_sg_c, y_dn_c, y_at_c, lp)
    return out, out_c


def _clamped_swiglu(gu):
    g = jnp.minimum(gu[..., :D_EXPERT], SWIGLU_LIMIT)
    lin = jnp.clip(gu[..., D_EXPERT:], -SWIGLU_LIMIT, SWIGLU_LIMIT)
    return g * jax.nn.sigmoid(SWIGLU_ALPHA * g) * (lin + 1.0)


def _moe(h, lp):
    N, D = h.shape
    logits = (h @ lp["router_w"] + lp["router_b"]).astype(F32)
    top_val, top_idx = lax.top_k(logits, TOP_K)
    gate = jax.nn.softmax(top_val, axis=-1)
    M = N * TOP_K
    e_flat = top_idx.reshape(M)
    order = jnp.argsort(e_flat)
    e_sorted = e_flat[order]
    counts = jnp.bincount(e_flat, length=N_EXPERTS)
    padded = (counts + MOE_BLOCK - 1) // MOE_BLOCK * MOE_BLOCK
    pad_end = jnp.cumsum(padded)
    dest = (pad_end - padded)[e_sorted] + jnp.arange(M) - (jnp.cumsum(counts) - counts)[e_sorted]
    n_blocks = (M + MOE_BLOCK - 1) // MOE_BLOCK + N_EXPERTS
    n_slots = n_blocks * MOE_BLOCK
    slot_tok = jnp.full((n_slots,), N, jnp.int32).at[dest].set((order // TOP_K).astype(jnp.int32))
    slot_gate = jnp.zeros((n_slots,), F32).at[dest].set(gate.reshape(M)[order])
    block_expert = jnp.minimum(jnp.searchsorted(pad_end, jnp.arange(n_blocks) * MOE_BLOCK, side="right"),
                               N_EXPERTS - 1)
    h_pad = jnp.concatenate([h, jnp.zeros((1, D), h.dtype)], axis=0)

    def expert_block(acc, blk):
        tok, gw, e = blk
        gu = h_pad[tok] @ lp["exp_w_gu"][e] + lp["exp_b_gu"][e]
        y = _clamped_swiglu(gu) @ lp["exp_w_down"][e] + lp["exp_b_down"][e]
        return acc.at[tok].add((y * gw[:, None]).astype(acc.dtype)), None

    acc, _ = lax.scan(expert_block, jnp.zeros((N + 1, D), h.dtype),
                      (slot_tok.reshape(n_blocks, MOE_BLOCK), slot_gate.reshape(n_blocks, MOE_BLOCK), block_expert))
    return acc[:N]


def _layer(x, xc, mod, mod_c, lp, row, col, need_ctx_out):
    sh1, sc1, g1, sh2, sc2, g2 = jnp.split(mod, 6, axis=-1)
    sh1c, sc1c, g1c, sh2c, sc2c, g2c = jnp.split(mod_c, 6, axis=-1)
    h = _rms_norm(x, lp["norm_pre_mix"]) * (1.0 + sc1) + sh1
    hc = _rms_norm(xc, lp["norm_pre_mix"]) * (1.0 + sc1c) + sh1c
    y, yc = _mixer(h, hc, lp, row, col, need_ctx_out)
    x = x + g1 * _rms_norm(y, lp["norm_post_mix"])
    B, S, D = x.shape
    h2 = _rms_norm(x, lp["norm_pre_ffn"]) * (1.0 + sc2) + sh2
    if need_ctx_out:
        xc = xc + g1c * _rms_norm(yc, lp["norm_post_mix"])
        L = xc.shape[1]
        h2c = _rms_norm(xc, lp["norm_pre_ffn"]) * (1.0 + sc2c) + sh2c
        yf = _moe(jnp.concatenate([h2.reshape(B * S, D), h2c.reshape(B * L, D)], axis=0), lp)
        y2 = yf[:B * S].reshape(B, S, D)
        xc = xc + g2c * _rms_norm(yf[B * S:].reshape(B, L, D), lp["norm_post_ffn"])
    else:
        y2 = _moe(h2.reshape(B * S, D), lp).reshape(B, S, D)
    x = x + g2 * _rms_norm(y2, lp["norm_post_ffn"])
    return x, xc


def _normal(k, shape, scale):
    return jax.random.normal(k, shape, F32) * scale


def setup_inputs(seed: int = 0) -> dict:
    key = jax.random.key(seed)
    ks = jax.random.split(key, 32)
    Dd, H = DEPTH, DN_HEADS
    dt = jnp.exp(jax.random.uniform(ks[15], (Dd, 2, H), F32, math.log(1e-3), math.log(1e-1)))
    return {
        "x": _normal(ks[0], (BATCH, SEQ, D_MODEL), 1.0),
        "c": _normal(ks[1], (BATCH, D_MODEL), 1.0),
        "ctx": _normal(ks[2], (BATCH, CTX_LEN, D_MODEL), 1.0),
        "c_ctx": _normal(ks[3], (D_MODEL,), 1.0),
        "w_mod": _normal(ks[4], (Dd, D_MODEL, 6 * D_MODEL), 0.5 * D_MODEL ** -0.5),
        "b_mod": _normal(ks[5], (Dd, 6 * D_MODEL), 0.01),
        "norm_pre_mix": 1.0 + _normal(ks[6], (Dd, D_MODEL), 0.05),
        "norm_post_mix": 1.0 + _normal(ks[7], (Dd, D_MODEL), 0.05),
        "norm_pre_ffn": 1.0 + _normal(ks[8], (Dd, D_MODEL), 0.05),
        "norm_post_ffn": 1.0 + _normal(ks[9], (Dd, D_MODEL), 0.05),
        "w_in": _normal(ks[10], (Dd, D_MODEL, D_IN), D_MODEL ** -0.5),
        "sg_ln_g": 1.0 + _normal(ks[11], (Dd, SG_WIDTH), 0.05),
        "sg_ln_b": _normal(ks[12], (Dd, SG_WIDTH), 0.01),
        "sg_w": _normal(ks[13], (Dd, SG_GROUPS, SG_CHUNK, SG_CHUNK), SG_CHUNK ** -0.5),
        "sg_b": 1.0 + _normal(ks[14], (Dd, SG_GROUPS, SG_CHUNK), 0.1),
        "dn_conv_w": _normal(ks[16], (Dd, DN_CONV, 3 * DN_WIDTH), DN_CONV ** -0.5),
        "dn_a_log": jnp.log(jax.random.uniform(ks[17], (Dd, 2, H), F32, 1.0, 16.0)),
        "dn_dt_bias": dt + jnp.log(-jnp.expm1(-dt)),
        "dn_norm_g": 1.0 + _normal(ks[18], (Dd, DN_DIM), 0.05),
        "at_sinks": _normal(ks[19], (Dd, AT_Q_HEADS), 1.0),
        "w_proj_sg": _normal(ks[20], (Dd, SG_WIDTH, D_MODEL), SG_WIDTH ** -0.5),
        "w_proj_dn": _normal(ks[21], (Dd, DN_WIDTH, D_MODEL), DN_WIDTH ** -0.5),
        "w_proj_at": _normal(ks[22], (Dd, AT_Q_WIDTH, D_MODEL), AT_Q_WIDTH ** -0.5),
        "w_out": _normal(ks[23], (Dd, D_MODEL, D_MODEL), D_MODEL ** -0.5),
        "router_w": _normal(ks[24], (Dd, D_MODEL, N_EXPERTS), D_MODEL ** -0.5),
        "router_b": _normal(ks[25], (Dd, N_EXPERTS), 0.01),
        "exp_w_gu": _normal(ks[26], (Dd, N_EXPERTS, D_MODEL, 2 * D_EXPERT), D_MODEL ** -0.5),
        "exp_b_gu": _normal(ks[27], (Dd, N_EXPERTS, 2 * D_EXPERT), 0.01),
        "exp_w_down": _normal(ks[28], (Dd, N_EXPERTS, D_EXPERT, D_MODEL), D_EXPERT ** -0.5),
        "exp_b_down": _normal(ks[29], (Dd, N_EXPERTS, D_MODEL), 0.01),
    }


def reference(x, c, ctx, c_ctx, w_mod, b_mod, norm_pre_mix, norm_post_mix, norm_pre_ffn, norm_post_ffn,
              w_in, sg_ln_g, sg_ln_b, sg_w, sg_b, dn_conv_w, dn_a_log, dn_dt_bias, dn_norm_g, at_sinks,
              w_proj_sg, w_proj_dn, w_proj_at, w_out, router_w, router_b, exp_w_gu, exp_b_gu, exp_w_down,
              exp_b_down):
    S = x.shape[1]
    ROWS = S // GRID_W
    row = jnp.repeat(jnp.arange(ROWS, dtype=jnp.int32), GRID_W)
    col = jnp.tile(jnp.arange(GRID_W, dtype=jnp.int32), ROWS)
    params = {
        "w_mod": w_mod, "b_mod": b_mod, "norm_pre_mix": norm_pre_mix, "norm_post_mix": norm_post_mix,
        "norm_pre_ffn": norm_pre_ffn, "norm_post_ffn": norm_post_ffn, "w_in": w_in,
        "sg_ln_g": sg_ln_g, "sg_ln_b": sg_ln_b, "sg_w": sg_w, "sg_b": sg_b,
        "dn_conv_w": dn_conv_w, "dn_a_log": dn_a_log, "dn_dt_bias": dn_dt_bias, "dn_norm_g": dn_norm_g,
        "at_sinks": at_sinks, "w_proj_sg": w_proj_sg, "w_proj_dn": w_proj_dn, "w_proj_at": w_proj_at,
        "w_out": w_out, "router_w": router_w, "router_b": router_b, "exp_w_gu": exp_w_gu,
        "exp_b_gu": exp_b_gu, "exp_w_down": exp_w_down, "exp_b_down": exp_b_down,
    }
    xc = ctx
    for l in range(DEPTH):
        lp = {name: p[l] for name, p in params.items()}
        mod = (jax.nn.silu(c) @ lp["w_mod"] + lp["b_mod"])[:, None, :]
        mod_c = jax.nn.silu(c_ctx) @ lp["w_mod"] + lp["b_mod"]
        x, xc = _layer(x, xc, mod, mod_c, lp, row, col, l < DEPTH - 1)
    return x
```

```cpp
#include <hip/hip_runtime.h>
#include <cstdio>
#include <cstdint>

#define GAS __attribute__((address_space(1)))
#define LAS __attribute__((address_space(3)))
typedef unsigned short bf16;
typedef unsigned v4u __attribute__((ext_vector_type(4)));
typedef unsigned v2u __attribute__((ext_vector_type(2)));
typedef float f32x4 __attribute__((ext_vector_type(4)));
typedef float f32x2 __attribute__((ext_vector_type(2)));
typedef short bf16x8 __attribute__((ext_vector_type(8)));
typedef float f32x16 __attribute__((ext_vector_type(16)));

constexpr int D = 1024, NB = 8, SEQ = 4096, CTXL = 256;
constexpr int NL = NB * SEQ, NC = NB * CTXL, MT = NL + NC;
constexpr int DIN = 10528, NP = 10752;
constexpr int C_DNK = 0, C_DNV = 1024, C_ATK = 2048, C_ATV = 2176, C_DNA = 2304, C_DNB = 2320, C_DNQ = 2560, C_DNG = 3584, C_ATQ = 4608, C_SGU = 5632, C_SGV = 6656, C_GATE = 7680;
constexpr int NEXP = 32, TOPK = 4, DE = 1024;
constexpr float EPS = 1e-6f;
constexpr int MAXPAN = 640;

constexpr size_t MiB = 1u << 20;
constexpr size_t WS_CTL = 0, CTL_ZERO_BYTES = 1 * MiB;
constexpr size_t WS_MOD = 1 * MiB;
constexpr size_t WS_WTIN = 2 * MiB;
constexpr size_t WS_WTPROJ = 44 * MiB;
constexpr size_t WS_WTGU = 60 * MiB;
constexpr size_t WS_WOUT8 = WS_WTGU + 192 * MiB;
constexpr size_t WS_WTDN = 316 * MiB;
constexpr size_t WS_H = 444 * MiB;
constexpr size_t WS_X = 512 * MiB;
constexpr size_t WS_Y3 = 648 * MiB;
constexpr size_t WS_MF = 852 * MiB;
constexpr size_t WS_MB = 988 * MiB;
constexpr size_t WS_P = 1056 * MiB;
constexpr size_t WS_XG = WS_P, WS_ACT = WS_P + 288 * MiB, WS_YS = WS_P;
constexpr size_t WS_QN = 1770 * MiB, WS_KN = 1838 * MiB, WS_VN = 1906 * MiB;
constexpr size_t WS_LDEC = 1974 * MiB, WS_BETA = 1977 * MiB;
constexpr size_t WS_TOPI = 1980 * MiB, WS_GATE = 1981 * MiB, WS_SLOT = 1982 * MiB;
constexpr size_t WS_MOE = 1983 * MiB;
constexpr size_t WS_CNT = 1984 * MiB;
constexpr size_t WS_ROWMAP = 1985 * MiB;
constexpr size_t WS_VTL = 1990 * MiB, WS_VTC = 1998 * MiB;
constexpr size_t WS_TREC = WS_H, WS_QKREC = WS_MB;
constexpr size_t WS_VEC = 1999 * MiB;
constexpr size_t WS_END = 2048 * MiB;
constexpr int CW_BAR = 4096, CW_ATTQ = 8192;

constexpr int RING_BYTES = 131072;
constexpr int MISC_OFF = RING_BYTES;
constexpr int LDS_BYTES = 147456;

__device__ __forceinline__ float bflo(unsigned u) { return __uint_as_float(u << 16); }
__device__ __forceinline__ float bfhi(unsigned u) { return __uint_as_float(u & 0xffff0000u); }
__device__ __forceinline__ float bf1(bf16 b) { return __uint_as_float(((unsigned)b) << 16); }
__device__ __forceinline__ unsigned pk2(float lo, float hi) { unsigned r; asm volatile("v_cvt_pk_bf16_f32 %0, %1, %2" : "=v"(r) : "v"(lo), "v"(hi)); return r; }
__device__ __forceinline__ unsigned f2bf(float f) { return pk2(f, f) & 0xffffu; }
__device__ __forceinline__ float wave_sum(float v) {
#pragma unroll
    for (int o = 1; o < 64; o <<= 1) v += __shfl_xor(v, o);
    return v;
}
__device__ __forceinline__ float wave_max(float v) {
#pragma unroll
    for (int o = 1; o < 64; o <<= 1) v = fmaxf(v, __shfl_xor(v, o));
    return v;
}
__device__ __forceinline__ void ld16(const bf16* p, float (&f)[16]) {
    const v4u a = *(const v4u*)p, b = *(const v4u*)(p + 8);
    f[0] = bflo(a.x); f[1] = bfhi(a.x); f[2] = bflo(a.y); f[3] = bfhi(a.y); f[4] = bflo(a.z); f[5] = bfhi(a.z); f[6] = bflo(a.w); f[7] = bfhi(a.w);
    f[8] = bflo(b.x); f[9] = bfhi(b.x); f[10] = bflo(b.y); f[11] = bfhi(b.y); f[12] = bflo(b.z); f[13] = bfhi(b.z); f[14] = bflo(b.w); f[15] = bfhi(b.w);
}
__device__ __forceinline__ void st16(bf16* p, const float (&f)[16]) {
    v4u a, b;
    a.x = pk2(f[0], f[1]); a.y = pk2(f[2], f[3]); a.z = pk2(f[4], f[5]); a.w = pk2(f[6], f[7]);
    b.x = pk2(f[8], f[9]); b.y = pk2(f[10], f[11]); b.z = pk2(f[12], f[13]); b.w = pk2(f[14], f[15]);
    *(v4u*)p = a; *(v4u*)(p + 8) = b;
}
__device__ __forceinline__ float fexp(float x) { return __builtin_amdgcn_exp2f(x * 1.4426950408889634f); }
__device__ __forceinline__ float frcp(float x) { return __builtin_amdgcn_rcpf(x); }
__device__ __forceinline__ float sigmoidf_(float x) { return frcp(1.0f + fexp(-x)); }
__device__ __forceinline__ float siluf_(float x) { return x * frcp(1.0f + fexp(-x)); }
__device__ __forceinline__ float gelu_tanh(float x) { const float u2 = 1.5957691216057308f * (x + 0.044715f * x * x * x); return x * frcp(1.0f + fexp(-u2)); }
__device__ __forceinline__ float softplusf_(float x) { return fmaxf(x, 0.0f) + log1pf(fexp(-fabsf(x))); }
__device__ __forceinline__ int lane_fresh() { int r; asm volatile("v_mbcnt_lo_u32_b32 %0, -1, 0\n\tv_mbcnt_hi_u32_b32 %0, -1, %0" : "=v"(r)); return r; }
__device__ __forceinline__ int hide(int x) { asm volatile("" : "+v"(x)); return x; }
#define LDS_WAIT() asm volatile("s_waitcnt lgkmcnt(0)" ::: "memory")
#define VM_WAIT() asm volatile("s_waitcnt vmcnt(0)" ::: "memory")

#define XB_TMO      128
#define XB_XCNT(j)  (256  + 64 * (j))
#define XB_XSUB(j)  (1280 + 64 * (j))
#define XB_XGEN(j)  (2304 + 64 * (j))
#define XB_TOP      3328
#define XB_TOPGEN   3392
#define XCD_BAR_WORDS 3456
#define XB_SPIN_CAP (1u << 22)

__device__ __forceinline__ unsigned xb_ld(unsigned* p)              { return __hip_atomic_load(p, __ATOMIC_RELAXED, __HIP_MEMORY_SCOPE_AGENT); }
__device__ __forceinline__ unsigned xb_add(unsigned* p, unsigned v) { return __hip_atomic_fetch_add(p, v, __ATOMIC_RELAXED, __HIP_MEMORY_SCOPE_AGENT); }
__device__ __forceinline__ unsigned xb_xcc_id() { return (unsigned)__builtin_amdgcn_s_getreg((3 << 11) | 20) & 0xFu; }
#define XB_SPIN(cond, bar) do { unsigned _sp = 0; while (cond) { __builtin_amdgcn_s_sleep(1); \
    if ((++_sp & 255u) == 0u) { if (xb_ld(&(bar)[XB_TMO])) break; if (_sp > XB_SPIN_CAP) { atomicAdd(&(bar)[XB_TMO], 1u); break; } } } } while (0)

struct XcdBarrier { unsigned* bar; unsigned x; volatile LAS unsigned* st; };

__device__ __forceinline__ XcdBarrier xcd_barrier_post(unsigned* bar, volatile LAS unsigned* st) {
    XcdBarrier b; b.bar = bar; b.x = xb_xcc_id(); b.st = st;
    if (threadIdx.x == 0) (void)xb_add(&bar[XB_XCNT(b.x)], 1u);
    return b;
}
__device__ __forceinline__ void xcd_barrier_complete(unsigned* bar, unsigned x, unsigned& nloc, unsigned& nx) {
    const unsigned G = gridDim.x * gridDim.y * gridDim.z;
    unsigned sum, cnt, mine, sp = 0u;
    for (;;) {
        sum = 0u; cnt = 0u; mine = 0u;
#pragma unroll
        for (unsigned j = 0; j < 16; ++j) { const unsigned c = xb_ld(&bar[XB_XCNT(j)]); sum += c; cnt += (c > 0u) ? 1u : 0u; mine = (j == x) ? c : mine; }
        if (sum == G) break;
        __builtin_amdgcn_s_sleep(1);
        if ((++sp & 255u) == 0u) { if (xb_ld(&bar[XB_TMO])) break; if (sp > XB_SPIN_CAP) { atomicAdd(&bar[XB_TMO], 1u); break; } }
    }
    nloc = mine > 0u ? mine : 1u; nx = cnt > 0u ? cnt : 1u;
}
__device__ __forceinline__ void xcd_barrier(const XcdBarrier& b) {
    asm volatile("s_waitcnt vmcnt(0)" ::: "memory");
    __syncthreads();
    if (threadIdx.x == 0) {
        unsigned* bar = b.bar;
        __builtin_amdgcn_s_waitcnt(0);
        unsigned nloc = b.st[0], nx = b.st[1];
        if (nloc == 0u) { xcd_barrier_complete(bar, b.x, nloc, nx); b.st[0] = nloc; b.st[1] = nx; }
        const unsigned old = xb_add(&bar[XB_XSUB(b.x)], 1u);
        const unsigned gen = old / nloc;
        if (old + 1u == (gen + 1u) * nloc) {
            __builtin_amdgcn_fence(__ATOMIC_RELEASE, "agent");
            asm volatile("s_waitcnt vmcnt(0)" ::: "memory");
            const unsigned og = xb_add(&bar[XB_TOP], 1u);
            const unsigned tg = og / nx;
            if (og + 1u == (tg + 1u) * nx) xb_add(&bar[XB_TOPGEN], 1u);
            else XB_SPIN(xb_ld(&bar[XB_TOPGEN]) == tg, bar);
            __builtin_amdgcn_fence(__ATOMIC_ACQUIRE, "agent");
            xb_add(&bar[XB_XGEN(b.x)], 1u);
            asm volatile("s_waitcnt vmcnt(0)" ::: "memory");
        } else {
            XB_SPIN(xb_ld(&bar[XB_XGEN(b.x)]) == gen, bar);
            __builtin_amdgcn_fence(__ATOMIC_ACQUIRE, "agent");
            asm volatile("s_waitcnt vmcnt(0)" ::: "memory");
        }
    }
    __syncthreads();
}

typedef int v8i __attribute__((ext_vector_type(8)));
typedef int v4i __attribute__((ext_vector_type(4)));
namespace pg8 {
constexpr int BM = 256, BK = 64, HALF = 128, HTB = HALF * BK * 2, STAGE_BYTES = 8 * HTB, NXCD = 8, WGM = 8;
__host__ __device__ __forceinline__ int lds_byte(int r, int c) { const int st = (r >> 4) * 2 + (c >> 5), rr = r & 15, cc = c & 31, ob = rr * 64 + cc * 2; return st * 1024 + (ob ^ (((ob >> 9) & 1) << 5)); }
__host__ __device__ __forceinline__ void stage_rc(int b, int& R, int& C) { const int st = b / 1024, sb = b % 1024, swz = sb ^ (((sb >> 9) & 1) << 5); R = (st >> 1) * 16 + swz / 64; C = (st & 1) * 32 + (swz % 64) / 2; }
__host__ __device__ __forceinline__ int perm32(int rho) { const int n = rho >> 4, i = rho & 15; return 8 * (i >> 2) + 4 * n + (i & 3); }

struct Unit { int pm, pn, z; };

__device__ __forceinline__ void rect_map(int L, int nM, int nN, int& pm, int& pn) {
    const int nwg = nM * nN;
    int wgid = L; { const int q = nwg / NXCD, r = nwg % NXCD, xcd = wgid % NXCD, off = wgid / NXCD; wgid = (xcd < r ? xcd * (q + 1) : r * (q + 1) + (xcd - r) * q) + off; }
    const int nig = WGM * nN, gid = wgid / nig, fm = gid * WGM, gsz = (nM - fm) < WGM ? (nM - fm) : WGM;
    pm = fm + ((wgid % nig) % gsz); pn = (wgid % nig) / gsz;
}
struct OrderRect2 {
    const char* A; const char* Bt; int nM0, nN0, nM1, nN1, G, c; size_t tile;
    __device__ __forceinline__ bool next(int i, Unit& u) const {
        long L = (long)i * G + c; const int n0 = nM0 * nN0, n1 = nM1 * nN1;
        if (L < n0) { rect_map((int)L, nM0, nN0, u.pm, u.pn); u.z = 0; return true; }
        L -= n0;
        if (L < n1) { rect_map((int)L, nM1, nN1, u.pm, u.pn); u.pm += nM0; u.z = 0; return true; }
        return false;
    }
    __device__ __forceinline__ const char* aptr(const Unit& u) const { return A + (size_t)u.pm * tile; }
    __device__ __forceinline__ const char* bptr(const Unit& u) const { return Bt + (size_t)u.pn * tile; }
};
struct OrderMerge {
    const char* A; const char* Bt; int nM, nN, G, c; size_t a_stride, b_stride;
    __device__ __forceinline__ bool next(int i, Unit& u) const {
        const int round = i / 3, br = i - 3 * round; const long L = (long)round * G + c;
        if (L >= (long)nM * nN) return false;
        rect_map((int)L, nM, nN, u.pm, u.pn); u.z = br; return true;
    }
    __device__ __forceinline__ const char* aptr(const Unit& u) const { return A + (size_t)u.z * a_stride + (size_t)u.pm * (256 * 1024 * 2); }
    __device__ __forceinline__ const char* bptr(const Unit& u) const { return Bt + (size_t)u.z * b_stride + (size_t)u.pn * (256 * 1024 * 2); }
};
struct OrderMoe {
    const char* A; const char* Bt; int nP, nN, G, c; size_t e_stride, tile; const unsigned* p2e;
    __device__ __forceinline__ bool next(int i, Unit& u) const {
        const long L = (long)i * G + c; if (L >= (long)nP * nN) return false;
        rect_map((int)L, nP, nN, u.pm, u.pn); u.pm = __builtin_amdgcn_readfirstlane(u.pm); u.pn = __builtin_amdgcn_readfirstlane(u.pn); u.z = (int)p2e[u.pm]; return true;
    }
    __device__ __forceinline__ const char* aptr(const Unit& u) const { return A + (size_t)u.pm * tile; }
    __device__ __forceinline__ const char* bptr(const Unit& u) const { return Bt + (size_t)u.z * e_stride + (size_t)u.pn * tile; }
};

struct OrderMoeG {
    const char* A; const char* Bt; int nP, nN, G, c; size_t e_stride, b_tile; const unsigned* p2e; const int* rowmap;
    __device__ __forceinline__ bool next(int i, Unit& u) const {
        const long L = (long)i * G + c; if (L >= (long)nP * nN) return false;
        rect_map((int)L, nP, nN, u.pm, u.pn); u.pm = __builtin_amdgcn_readfirstlane(u.pm); u.pn = __builtin_amdgcn_readfirstlane(u.pn); u.z = (int)p2e[u.pm]; return true;
    }
    __device__ __forceinline__ const char* aptr(const Unit&) const { return A; }
    __device__ __forceinline__ const char* bptr(const Unit& u) const { return Bt + (size_t)u.z * e_stride + (size_t)u.pn * b_tile; }
};
__device__ __forceinline__ unsigned cvt_pk_bf16(float lo, float hi) { unsigned r; asm volatile("v_cvt_pk_bf16_f32 %0, %1, %2" : "=v"(r) : "v"(lo), "v"(hi)); return r; }

struct EpiStoreBf16 {
    static constexpr bool PERM = true, MUT = false;
    bf16* O; int ldc;
    __device__ __forceinline__ void operator()(const f32x4 (&acc)[2][2][4][2], const Unit& u, int wr, int wc, int fr, int fq) const {
        const int row0 = u.pm * BM + wr * 64 + fr, col0 = u.pn * BM + wc * 32 + 8 * fq;
#pragma unroll
        for (int ai = 0; ai < 2; ++ai)
#pragma unroll
            for (int m = 0; m < 4; ++m) { bf16* rowp = O + (size_t)(row0 + ai * HALF + m * 16) * ldc + col0;
#pragma unroll
                for (int bj = 0; bj < 2; ++bj) { const f32x4 v0 = acc[ai][bj][m][0], v1 = acc[ai][bj][m][1];
                    v4u w; w.x = cvt_pk_bf16(v0[0], v0[1]); w.y = cvt_pk_bf16(v0[2], v0[3]); w.z = cvt_pk_bf16(v1[0], v1[1]); w.w = cvt_pk_bf16(v1[2], v1[3]);
                    __builtin_nontemporal_store(w, (v4u*)(rowp + bj * HALF)); } }
    }
};
struct EpiF32 {
    static constexpr bool PERM = false, MUT = false;
    float* C;
    __device__ __forceinline__ void operator()(const f32x4 (&acc)[2][2][4][2], const Unit& u, int wr, int wc, int fr, int fq) const {
        const int row0 = u.pm * BM + wr * 64 + fr, col0 = u.pn * BM + wc * 32 + 4 * fq;
#pragma unroll
        for (int ai = 0; ai < 2; ++ai)
#pragma unroll
            for (int m = 0; m < 4; ++m) { float* rowp = C + (size_t)(row0 + ai * HALF + m * 16) * 1024 + col0;
#pragma unroll
                for (int bj = 0; bj < 2; ++bj)
#pragma unroll
                    for (int n = 0; n < 2; ++n) *(f32x4*)(rowp + bj * HALF + n * 16) = acc[ai][bj][m][n]; }
    }
};
struct EpiMerge {
    static constexpr bool PERM = true, MUT = true;
    const bf16* Pg; bf16* MB;
    __device__ __forceinline__ void mut(f32x4 (&acc)[2][2][4][2], const Unit& u, int wr, int wc, int fr, int fq) const {
        const int row0 = u.pm * BM + wr * 64 + fr, col0 = u.pn * BM + wc * 32 + 8 * fq; const int br = u.z;
        v4u gv[16];
#pragma unroll
        for (int ai = 0; ai < 2; ++ai)
#pragma unroll
            for (int m = 0; m < 4; ++m)
#pragma unroll
                for (int bj = 0; bj < 2; ++bj) gv[(ai * 4 + m) * 2 + bj] = *(const v4u*)(Pg + (size_t)(row0 + ai * HALF + m * 16) * NP + br * 1024 + col0 + bj * HALF);
#pragma unroll
        for (int ai = 0; ai < 2; ++ai)
#pragma unroll
            for (int m = 0; m < 4; ++m) { const size_t r = (size_t)(row0 + ai * HALF + m * 16);
#pragma unroll
                for (int bj = 0; bj < 2; ++bj) { const int c = col0 + bj * HALF; const v4u ga = gv[(ai * 4 + m) * 2 + bj];
                    f32x4 v0 = acc[ai][bj][m][0], v1 = acc[ai][bj][m][1];
                    v0[0] *= bflo(ga.x); v0[1] *= bfhi(ga.x); v0[2] *= bflo(ga.y); v0[3] *= bfhi(ga.y); v1[0] *= bflo(ga.z); v1[1] *= bfhi(ga.z); v1[2] *= bflo(ga.w); v1[3] *= bfhi(ga.w);
                    acc[ai][bj][m][0] = v0; acc[ai][bj][m][1] = v1;
                    if (br == 2) { v2u w; w.x = __builtin_amdgcn_cvt_pk_fp8_f32(v0[0], v0[1], 0, false); w.x = __builtin_amdgcn_cvt_pk_fp8_f32(v0[2], v0[3], w.x, true);
                        w.y = __builtin_amdgcn_cvt_pk_fp8_f32(v1[0], v1[1], 0, false); w.y = __builtin_amdgcn_cvt_pk_fp8_f32(v1[2], v1[3], w.y, true);
                        *(v2u*)((unsigned char*)MB + r * 1024 + c) = w; } } }
    }
};
struct EpiSwiglu {
    static constexpr bool PERM = true, MUT = false;
    bf16* ACT; const float* bgu; float ascale;
    __device__ __forceinline__ void operator()(const f32x4 (&acc)[2][2][4][2], const Unit& u, int wr, int wc, int fr, int fq) const {
        const int row0 = u.pm * BM + wr * 64 + fr, colg = u.pn * HALF + wc * 32 + 8 * fq;
        const float* bp = bgu + (size_t)u.z * 2048 + colg;
        const f32x4 bg0 = *(const f32x4*)bp, bg1 = *(const f32x4*)(bp + 4), bl0 = *(const f32x4*)(bp + 1024), bl1 = *(const f32x4*)(bp + 1028);
#pragma unroll
        for (int ai = 0; ai < 2; ++ai)
#pragma unroll
            for (int m = 0; m < 4; ++m) {
                f32x4 g0 = acc[ai][0][m][0] * ascale + bg0, g1 = acc[ai][0][m][1] * ascale + bg1, l0 = acc[ai][1][m][0] * ascale + bl0, l1 = acc[ai][1][m][1] * ascale + bl1;
                f32x4 o0, o1;
#pragma unroll
                for (int j = 0; j < 4; ++j) {
                    const float ga = __builtin_amdgcn_fmed3f(g0[j], -3.0e38f, 7.0f), la = __builtin_amdgcn_fmed3f(l0[j], -7.0f, 7.0f); o0[j] = ga * sigmoidf_(1.702f * ga) * (la + 1.0f);
                    const float gb = __builtin_amdgcn_fmed3f(g1[j], -3.0e38f, 7.0f), lb = __builtin_amdgcn_fmed3f(l1[j], -7.0f, 7.0f); o1[j] = gb * sigmoidf_(1.702f * gb) * (lb + 1.0f); }
                v2u w; w.x = __builtin_amdgcn_cvt_pk_fp8_f32(o0[0], o0[1], 0, false); w.x = __builtin_amdgcn_cvt_pk_fp8_f32(o0[2], o0[3], w.x, true);
                w.y = __builtin_amdgcn_cvt_pk_fp8_f32(o1[0], o1[1], 0, false); w.y = __builtin_amdgcn_cvt_pk_fp8_f32(o1[2], o1[3], w.y, true);
                *(v2u*)((unsigned char*)ACT + (size_t)(row0 + ai * HALF + m * 16) * 1024 + colg) = w; }
    }
};
struct EpiDown {
    static constexpr bool PERM = true, MUT = false;
    bf16* YS; const float* bd; float ascale;
    __device__ __forceinline__ void operator()(const f32x4 (&acc)[2][2][4][2], const Unit& u, int wr, int wc, int fr, int fq) const {
        const int row0 = u.pm * BM + wr * 64 + fr, col0 = u.pn * BM + wc * 32 + 8 * fq;
        const float* bp = bd + (size_t)u.z * 1024 + col0;
        f32x4 bv[2][2];
#pragma unroll
        for (int bj = 0; bj < 2; ++bj)
#pragma unroll
            for (int n = 0; n < 2; ++n) bv[bj][n] = *(const f32x4*)(bp + bj * HALF + 4 * n);
#pragma unroll
        for (int ai = 0; ai < 2; ++ai)
#pragma unroll
            for (int m = 0; m < 4; ++m) { bf16* rowp = YS + (size_t)(row0 + ai * HALF + m * 16) * 1024 + col0;
#pragma unroll
                for (int bj = 0; bj < 2; ++bj) { const f32x4 v0 = acc[ai][bj][m][0] * ascale + bv[bj][0], v1 = acc[ai][bj][m][1] * ascale + bv[bj][1];
                    v4u w; w.x = cvt_pk_bf16(v0[0], v0[1]); w.y = cvt_pk_bf16(v0[2], v0[3]); w.z = cvt_pk_bf16(v1[0], v1[1]); w.w = cvt_pk_bf16(v1[2], v1[3]);
                    *(v4u*)(rowp + bj * HALF) = w; } }
    }
};

template <class Epi, class Sched, bool GATHER = false, bool FP8 = false>
__device__ __forceinline__ void gemm_phase(LAS unsigned char* lds, const Sched& S, const Epi& E, const int wave_id) {
    const int wid = wave_id, lane = lane_fresh(), tid = wid * 64 + lane, wr = wid >> 2, wc = wid & 3, fr = lane & 15, fq = lane >> 4;
    constexpr int K = 1024, KB = FP8 ? 1024 : 2048, nt = KB / (BK * 2);
    unsigned voffA[2], voffB[2]; int gR[2], gC[2];
#pragma unroll
    for (int i = 0; i < 2; ++i) { int R, C; stage_rc(tid * 16 + i * 8192, R, C); const int Rb = Epi::PERM ? ((R & ~31) + perm32(R & 31)) : R; gR[i] = R; gC[i] = C;
        voffA[i] = (unsigned)(R * KB + C * 2); voffB[i] = (unsigned)(Rb * KB + C * 2); }
    unsigned vaC[2][2], vaN[2][2];
    int rmN[2][2];
#define PG8_RLOAD(dst, un) do { _Pragma("unroll") for (int hf = 0; hf < 2; ++hf) _Pragma("unroll") for (int i = 0; i < 2; ++i) dst[hf][i] = S.rowmap[(un).pm * 256 + hf * 128 + gR[i]]; } while (0)
#define PG8_RCONV(dst, src) do { _Pragma("unroll") for (int hf = 0; hf < 2; ++hf) _Pragma("unroll") for (int i = 0; i < 2; ++i) dst[hf][i] = (unsigned)(src[hf][i] * KB + gC[i] * 2); } while (0)
    const size_t kstep = (size_t)(BK * 2);
    const size_t hstep = (size_t)HALF * KB;
    const unsigned ldsw = (unsigned)wid * 1024u;
    const int aoff = lds_byte(wr * 64 + fr, fq * 8), boff = lds_byte(wc * 32 + fr, fq * 8);
#define PG8_SA(b, h) (((b) * 2 + (h)) * HTB)
#define PG8_SB(b, h) ((4 + (b) * 2 + (h)) * HTB)
#define PG8_STAGE(bufoff, gbase, voff) do { _Pragma("unroll") for (int _i = 0; _i < 2; ++_i) \
        __builtin_amdgcn_global_load_lds((const unsigned*)((const char*)(gbase) + (voff)[_i]), (LAS unsigned*)(lds + (bufoff) + ldsw + _i * 8192), 16, 0, 0); } while (0)
#define PG8_LDA(dst, b, h) do { if constexpr (FP8) { _Pragma("unroll") for (int m = 0; m < 4; ++m) { const v4i lo_ = *(const LAS v4i*)(lds + PG8_SA(b, h) + aoff + m * 2048), hi_ = *(const LAS v4i*)(lds + PG8_SA(b, h) + aoff + m * 2048 + 1024); dst##8[m] = __builtin_shufflevector(lo_, hi_, 0, 1, 2, 3, 4, 5, 6, 7); } } \
        else { _Pragma("unroll") for (int m = 0; m < 4; ++m) _Pragma("unroll") for (int k = 0; k < 2; ++k) dst[m][k] = *(const LAS bf16x8*)(lds + PG8_SA(b, h) + aoff + m * 2048 + k * 1024); } } while (0)
#define PG8_LDB(dst, b, h) do { if constexpr (FP8) { _Pragma("unroll") for (int n = 0; n < 2; ++n) { const v4i lo_ = *(const LAS v4i*)(lds + PG8_SB(b, h) + boff + n * 2048), hi_ = *(const LAS v4i*)(lds + PG8_SB(b, h) + boff + n * 2048 + 1024); dst##8[n] = __builtin_shufflevector(lo_, hi_, 0, 1, 2, 3, 4, 5, 6, 7); } } \
        else { _Pragma("unroll") for (int n = 0; n < 2; ++n) _Pragma("unroll") for (int k = 0; k < 2; ++k) dst[n][k] = *(const LAS bf16x8*)(lds + PG8_SB(b, h) + boff + n * 2048 + k * 1024); } } while (0)
#define PG8_MMA(ai, bj, At, Bt) do { __builtin_amdgcn_s_setprio(1); if constexpr (FP8) { _Pragma("unroll") for (int m = 0; m < 4; ++m) _Pragma("unroll") for (int n = 0; n < 2; ++n) \
            asm volatile("v_mfma_f32_16x16x128_f8f6f4 %0, %1, %2, %0" : "+v"(acc[ai][bj][m][n]) : "v"(Bt##8[n]), "v"(At##8[m])); } \
        else { _Pragma("unroll") for (int m = 0; m < 4; ++m) _Pragma("unroll") for (int n = 0; n < 2; ++n) _Pragma("unroll") for (int k = 0; k < 2; ++k) \
        acc[ai][bj][m][n] = __builtin_amdgcn_mfma_f32_16x16x32_bf16(Bt[n][k], At[m][k], acc[ai][bj][m][n], 0, 0, 0); } __builtin_amdgcn_s_setprio(0); } while (0)
#define PG8_WAIT_V(n) asm volatile("s_waitcnt vmcnt(" #n ")" ::: "memory")
#define PG8_WAIT_L(n) asm volatile("s_waitcnt lgkmcnt(" #n ")" ::: "memory")
#define PG8_BAR __builtin_amdgcn_s_barrier()
#define PG8_SCHED __builtin_amdgcn_sched_barrier(0)
    Unit cur, nxt; int ui = 0;
    if (!S.next(0, cur)) return;
    f32x4 acc[2][2][4][2];
#pragma unroll
    for (int a = 0; a < 2; ++a)
#pragma unroll
        for (int b = 0; b < 2; ++b)
#pragma unroll
            for (int m = 0; m < 4; ++m)
#pragma unroll
                for (int n = 0; n < 2; ++n) acc[a][b][m][n] = (f32x4){0.f, 0.f, 0.f, 0.f};
    bf16x8 At[4][2], B0[2][2], B1[2][2];
    v8i At8[4], B08[2], B18[2];
    const char* cA = S.aptr(cur); const char* cB = S.bptr(cur);
    if constexpr (GATHER) { int rm0[2][2]; PG8_RLOAD(rm0, cur); PG8_RCONV(vaC, rm0); Unit n1; if (S.next(1, n1)) PG8_RLOAD(rmN, n1); }
#define PG8_STAGE_A(bufoff, gbase, hf, useN) do { if constexpr (GATHER) { if (useN) PG8_STAGE(bufoff, gbase, vaN[hf]); else PG8_STAGE(bufoff, gbase, vaC[hf]); } else PG8_STAGE(bufoff, (gbase) + (hf) * hstep, voffA); } while (0)
    PG8_STAGE(PG8_SB(0, 0), cB, voffB); PG8_STAGE_A(PG8_SA(0, 0), cA, 0, false); PG8_STAGE(PG8_SB(0, 1), cB + hstep, voffB); PG8_STAGE_A(PG8_SA(0, 1), cA, 1, false);
    if (wr == 1) PG8_BAR;
    PG8_WAIT_V(4); PG8_BAR;
    PG8_STAGE(PG8_SB(1, 0), cB + kstep, voffB); PG8_STAGE_A(PG8_SA(1, 0), cA + kstep, 0, false); PG8_STAGE(PG8_SB(1, 1), cB + hstep + kstep, voffB);
    PG8_WAIT_V(6); PG8_BAR;
    for (;;) {
        const bool has_next = S.next(ui + 1, nxt);
        const char* nA = has_next ? S.aptr(nxt) : cA; const char* nB = has_next ? S.bptr(nxt) : cB;
        if constexpr (GATHER) { if (has_next) PG8_RCONV(vaN, rmN); else {
#pragma unroll
            for (int hf = 0; hf < 2; ++hf)
#pragma unroll
                for (int i = 0; i < 2; ++i) vaN[hf][i] = vaC[hf][i]; }
            Unit nn; if (S.next(ui + 2, nn)) PG8_RLOAD(rmN, nn); }
#pragma unroll 1
        for (int t = 0; t < nt; t += 2) {
            const bool last = (t == nt - 2);
            const char* a1 = cA + (size_t)(t + 1) * kstep;
            const char* a2 = last ? nA : cA + (size_t)(t + 2) * kstep; const char* b2 = last ? nB : cB + (size_t)(t + 2) * kstep;
            const char* a3 = a2 + kstep; const char* b3 = b2 + kstep;
            PG8_LDB(B0, 0, 0); PG8_SCHED; PG8_LDA(At, 0, 0); PG8_STAGE_A(PG8_SA(1, 1), a1, 1, false);
            PG8_WAIT_L(8); PG8_BAR; PG8_WAIT_L(0); PG8_MMA(0, 0, At, B0); PG8_BAR; PG8_SCHED;
            PG8_LDB(B1, 0, 1); PG8_STAGE(PG8_SB(0, 0), b2, voffB);
            PG8_BAR; PG8_WAIT_L(0); PG8_MMA(0, 1, At, B1); PG8_BAR;
            PG8_LDA(At, 0, 1); PG8_STAGE_A(PG8_SA(0, 0), a2, 0, last);
            PG8_BAR; PG8_WAIT_L(0); PG8_MMA(1, 0, At, B0); PG8_BAR; PG8_SCHED;
            PG8_STAGE(PG8_SB(0, 1), b2 + hstep, voffB);
            PG8_WAIT_V(6); PG8_BAR; PG8_MMA(1, 1, At, B1); PG8_BAR;
            PG8_LDB(B0, 1, 0); PG8_SCHED; PG8_LDA(At, 1, 0); PG8_STAGE_A(PG8_SA(0, 1), a2, 1, last);
            PG8_WAIT_L(8); PG8_BAR; PG8_WAIT_L(0); PG8_MMA(0, 0, At, B0); PG8_BAR; PG8_SCHED;
            PG8_LDB(B1, 1, 1); PG8_STAGE(PG8_SB(1, 0), b3, voffB);
            PG8_BAR; PG8_WAIT_L(0); PG8_MMA(0, 1, At, B1); PG8_BAR;
            PG8_LDA(At, 1, 1); PG8_STAGE_A(PG8_SA(1, 0), a3, 0, last);
            PG8_BAR; PG8_WAIT_L(0); PG8_MMA(1, 0, At, B0); PG8_BAR; PG8_SCHED;
            PG8_STAGE(PG8_SB(1, 1), b3 + hstep, voffB);
            PG8_WAIT_V(6); PG8_BAR; PG8_MMA(1, 1, At, B1); PG8_BAR;
        }
        if constexpr (FP8) asm volatile("s_nop 15\n\ts_nop 15" ::: "memory");
        bool keep = false;
        if constexpr (Epi::MUT) { E.mut(acc, cur, wr, wc, fr, fq); keep = cur.z != 2; } else { const int le_ = lane_fresh(); E(acc, cur, wr, wc, le_ & 15, le_ >> 4); }
        if (!has_next) break;
        if (!keep)
#pragma unroll
        for (int a = 0; a < 2; ++a)
#pragma unroll
            for (int b = 0; b < 2; ++b)
#pragma unroll
                for (int m = 0; m < 4; ++m)
#pragma unroll
                    for (int n = 0; n < 2; ++n) acc[a][b][m][n] = (f32x4){0.f, 0.f, 0.f, 0.f};
        cur = nxt; cA = nA; cB = nB; ++ui;
        if constexpr (GATHER) {
#pragma unroll
            for (int hf = 0; hf < 2; ++hf)
#pragma unroll
                for (int i = 0; i < 2; ++i) vaC[hf][i] = vaN[hf][i]; }
    }
    PG8_WAIT_V(0);
    if (wr == 0) PG8_BAR;
    PG8_BAR;
#undef PG8_SA
#undef PG8_SB
#undef PG8_STAGE
#undef PG8_STAGE_A
#undef PG8_RLOAD
#undef PG8_RCONV
#undef PG8_LDA
#undef PG8_LDB
#undef PG8_MMA
#undef PG8_WAIT_V
#undef PG8_WAIT_L
#undef PG8_BAR
#undef PG8_SCHED
}
}


constexpr int DN_NCH = 68, DN_ITEMS = 8 * 8 * 2 * DN_NCH;
__device__ __forceinline__ int dn_row(int b, int dir, int c, int i) {
    const bool cx = c < 4; const int len = cx ? CTXL : SEQ, base = cx ? NL + b * CTXL : b * SEQ, p = (cx ? c : c - 4) * 64 + i;
    return base + (dir ? len - 1 - p : p);
}
__device__ __forceinline__ bf16x8 pack_frag(const f32x16& x, const int s) {
    v4u p;
    if (s == 0) asm volatile("s_nop 15\n\tv_cvt_pk_bf16_f32 %0, %4, %5\n\tv_cvt_pk_bf16_f32 %1, %6, %7\n\tv_cvt_pk_bf16_f32 %2, %8, %9\n\tv_cvt_pk_bf16_f32 %3, %10, %11\n\ts_nop 1"
               : "=&v"(p[0]), "=&v"(p[1]), "=&v"(p[2]), "=&v"(p[3]) : "v"(x[0]), "v"(x[1]), "v"(x[2]), "v"(x[3]), "v"(x[4]), "v"(x[5]), "v"(x[6]), "v"(x[7]));
    else asm volatile("s_nop 15\n\tv_cvt_pk_bf16_f32 %0, %4, %5\n\tv_cvt_pk_bf16_f32 %1, %6, %7\n\tv_cvt_pk_bf16_f32 %2, %8, %9\n\tv_cvt_pk_bf16_f32 %3, %10, %11\n\ts_nop 1"
               : "=&v"(p[0]), "=&v"(p[1]), "=&v"(p[2]), "=&v"(p[3]) : "v"(x[8]), "v"(x[9]), "v"(x[10]), "v"(x[11]), "v"(x[12]), "v"(x[13]), "v"(x[14]), "v"(x[15]));
    return __builtin_bit_cast(bf16x8, p);
}
#define MFMA32(a, b, c) __builtin_amdgcn_mfma_f32_32x32x16_bf16((a), (b), (c), 0, 0, 0)
#define LDFRAG8(dst, addr, OFF) asm volatile("ds_read_b128 %0, %8 offset:%9\n\tds_read_b128 %1, %8 offset:%10\n\tds_read_b128 %2, %8 offset:%11\n\tds_read_b128 %3, %8 offset:%12\n\t" \
        "ds_read_b128 %4, %8 offset:%13\n\tds_read_b128 %5, %8 offset:%14\n\tds_read_b128 %6, %8 offset:%15\n\tds_read_b128 %7, %8 offset:%16\n\ts_waitcnt lgkmcnt(0)" \
        : "=&v"(dst[0]), "=&v"(dst[1]), "=&v"(dst[2]), "=&v"(dst[3]), "=&v"(dst[4]), "=&v"(dst[5]), "=&v"(dst[6]), "=&v"(dst[7]) \
        : "v"(addr), "n"((OFF)), "n"((OFF) + 1024), "n"((OFF) + 2048), "n"((OFF) + 3072), "n"((OFF) + 4096), "n"((OFF) + 5120), "n"((OFF) + 6144), "n"((OFF) + 7168) : "memory")
#define LDFRAG6(dst, addr, OFF) asm volatile("ds_read_b128 %0, %6 offset:%7\n\tds_read_b128 %1, %6 offset:%8\n\tds_read_b128 %2, %6 offset:%9\n\tds_read_b128 %3, %6 offset:%10\n\t" \
        "ds_read_b128 %4, %6 offset:%11\n\tds_read_b128 %5, %6 offset:%12\n\ts_waitcnt lgkmcnt(0)" \
        : "=&v"(dst[0]), "=&v"(dst[1]), "=&v"(dst[2]), "=&v"(dst[3]), "=&v"(dst[4]), "=&v"(dst[5]) \
        : "v"(addr), "n"((OFF)), "n"((OFF) + 1024), "n"((OFF) + 2048), "n"((OFF) + 3072), "n"((OFF) + 4096), "n"((OFF) + 5120) : "memory")

struct Args { const float* in[30]; float* out; unsigned char* ws; int ph_lo, ph_hi; };
enum { I_X = 0, I_C, I_CTX, I_CCTX, I_WMOD, I_BMOD, I_NPRE, I_NPOST, I_NPREF, I_NPOSTF, I_WIN, I_SGLNG, I_SGLNB, I_SGW, I_SGB, I_CONVW, I_ALOG, I_DTB, I_DNNG, I_SINK,
       I_WPSG, I_WPDN, I_WPAT, I_WOUT, I_RW, I_RB, I_WGU, I_BGU, I_WDN, I_BDN };

struct Fr {
    LAS unsigned char* lds; int tid, lane, wave, G, bx, gw, NGW;
    const float* in[30]; float* out; unsigned char* ws;
};

__device__ __forceinline__ int row_batch(int r) { return r < NL ? r / SEQ : (r - NL) / CTXL; }
__device__ __forceinline__ int mod_slot(int r) { return r < NL ? r / SEQ : 8; }

__device__ __forceinline__ void transpose_item(const float* W, int N, int k0, int n0, bf16* WT, int drow0, LAS float* scr, int lane) {
#pragma unroll 8
    for (int i = 0; i < 32; ++i) { const int kk = 2 * i + (lane >> 5); scr[kk * 33 + (lane & 31)] = W[(size_t)(k0 + kk) * N + n0 + (lane & 31)]; }
    LDS_WAIT();
    const int c = lane & 7;
#pragma unroll
    for (int j = 0; j < 4; ++j) { const int n = (lane >> 3) + 8 * j; const LAS float* s = scr + (8 * c) * 33 + n;
        v4u o; o.x = pk2(s[0 * 33], s[1 * 33]); o.y = pk2(s[2 * 33], s[3 * 33]); o.z = pk2(s[4 * 33], s[5 * 33]); o.w = pk2(s[6 * 33], s[7 * 33]);
        *(v4u*)(WT + (size_t)(drow0 + n) * 1024 + k0 + 8 * c) = o; }
    LDS_WAIT();
}

__device__ __forceinline__ void transpose_item_small(const float* W, int N, int k0, int n0, bf16* WT, int drow0, LAS float* scr, int lane) {
    const int kr = lane >> 3, c4 = lane & 7;
    f32x4 v[8];
#pragma unroll
    for (int i = 0; i < 8; ++i) v[i] = *(const f32x4*)(W + (size_t)(k0 + 8 * i + kr) * N + n0 + 4 * c4);
    const int n = lane & 31, kh = lane >> 5;
#pragma unroll
    for (int sub = 0; sub < 4; ++sub) {
#pragma unroll
        for (int hf = 0; hf < 2; ++hf) { LAS float* d = scr + (8 * hf + kr) * 33 + 4 * c4; const f32x4 w = v[2 * sub + hf]; d[0] = w.x; d[1] = w.y; d[2] = w.z; d[3] = w.w; }
        LDS_WAIT();
        const LAS float* sp = scr + (8 * kh) * 33 + n;
        v4u o; o.x = pk2(sp[0 * 33], sp[1 * 33]); o.y = pk2(sp[2 * 33], sp[3 * 33]); o.z = pk2(sp[4 * 33], sp[5 * 33]); o.w = pk2(sp[6 * 33], sp[7 * 33]);
        *(v4u*)(WT + (size_t)(drow0 + n) * 1024 + k0 + 16 * sub + 8 * kh) = o;
        LDS_WAIT();
    }
}

__device__ __forceinline__ void transpose_item_small8(const float* W, int N, int k0, int n0, unsigned char* WT8, int drow0, LAS float* scr, int lane) {
    const int kr = lane >> 3, c4 = lane & 7;
    f32x4 v[8];
#pragma unroll
    for (int i = 0; i < 8; ++i) v[i] = *(const f32x4*)(W + (size_t)(k0 + 8 * i + kr) * N + n0 + 4 * c4);
    const int n = lane & 31, kh = lane >> 5;
#pragma unroll
    for (int sub = 0; sub < 4; ++sub) {
#pragma unroll
        for (int hf = 0; hf < 2; ++hf) { LAS float* d = scr + (8 * hf + kr) * 33 + 4 * c4; const f32x4 w = v[2 * sub + hf] * 64.0f; d[0] = w.x; d[1] = w.y; d[2] = w.z; d[3] = w.w; }
        LDS_WAIT();
        const LAS float* sp = scr + (8 * kh) * 33 + n;
        v2u o; o.x = __builtin_amdgcn_cvt_pk_fp8_f32(sp[0 * 33], sp[1 * 33], 0, false); o.x = __builtin_amdgcn_cvt_pk_fp8_f32(sp[2 * 33], sp[3 * 33], o.x, true);
        o.y = __builtin_amdgcn_cvt_pk_fp8_f32(sp[4 * 33], sp[5 * 33], 0, false); o.y = __builtin_amdgcn_cvt_pk_fp8_f32(sp[6 * 33], sp[7 * 33], o.y, true);
        *(v2u*)(WT8 + (size_t)(drow0 + n) * 1024 + k0 + 16 * sub + 8 * kh) = o;
        LDS_WAIT();
    }
}
constexpr int CV_IT_GU = 16 * 64, CV_IT_DN = 16 * 32, CV_N_GU = 32 * CV_IT_GU, CV_N_DN = 32 * CV_IT_DN, CV_N_TOT = CV_N_GU + CV_N_DN;
constexpr int CV_E_QUOTA = 14, CV_F_QUOTA = 2;
__device__ __forceinline__ void expert_item(int it, int l, const float* wgu, const float* wdn, bf16* WTGU, bf16* WTDN, LAS float* scr, int lane) {
    int r = it;
    if (r < CV_N_GU) { const int e = r / CV_IT_GU; r -= e * CV_IT_GU; const int nb = r >> 4, kb = r & 15; const int n0 = 32 * nb; const size_t le = (size_t)l * 32 + e;
        const int drow = n0 < 1024 ? 256 * (n0 >> 7) + (n0 & 127) : 256 * ((n0 - 1024) >> 7) + 128 + ((n0 - 1024) & 127);
        transpose_item_small8(wgu + le * 1024 * 2048, 2048, 64 * kb, n0, (unsigned char*)WTGU + le * 2048 * 1024, drow, scr, lane); }
    else { r -= CV_N_GU; const int e = r / CV_IT_DN; r -= e * CV_IT_DN; const int nb = r >> 4, kb = r & 15; const size_t le = (size_t)l * 32 + e;
        transpose_item_small8(wdn + le * 1024 * 1024, 1024, 64 * kb, 32 * nb, (unsigned char*)WTDN + le * 1024 * 1024, 32 * nb, scr, lane); }
}
__device__ __forceinline__ void cv_proc(const f32x4 (&v)[8], bf16* dst, LAS float* scr, int lane) {
    const int kr = lane >> 3, c4 = lane & 7, n = lane & 31, kh = lane >> 5;
#pragma unroll
    for (int sub = 0; sub < 4; ++sub) {
#pragma unroll
        for (int hf = 0; hf < 2; ++hf) { LAS float* d = scr + (8 * hf + kr) * 33 + 4 * c4; const f32x4 w = v[2 * sub + hf]; d[0] = w.x; d[1] = w.y; d[2] = w.z; d[3] = w.w; }
        LDS_WAIT();
        const LAS float* sp = scr + (8 * kh) * 33 + n;
        v4u o; o.x = pk2(sp[0 * 33], sp[1 * 33]); o.y = pk2(sp[2 * 33], sp[3 * 33]); o.z = pk2(sp[4 * 33], sp[5 * 33]); o.w = pk2(sp[6 * 33], sp[7 * 33]);
        *(v4u*)(dst + 16 * sub) = o;
        LDS_WAIT();
    }
}

__device__ __forceinline__ void mod_rms_row(const float* xrow, const float* g, const float* sh, const float* sc, bf16* orow, int lane) {
    f32x4 v[4]; float s = 0.f;
#pragma unroll
    for (int j = 0; j < 4; ++j) { v[j] = ((const f32x4*)xrow)[64 * j + lane]; s += (v[j].x * v[j].x + v[j].y * v[j].y) + (v[j].z * v[j].z + v[j].w * v[j].w); }
    const float rinv = rsqrtf(wave_sum(s) * (1.f / D) + EPS);
#pragma unroll
    for (int j = 0; j < 4; ++j) { const f32x4 gg = ((const f32x4*)g)[64 * j + lane], a = ((const f32x4*)sc)[64 * j + lane], b = ((const f32x4*)sh)[64 * j + lane];
        const f32x4 h = v[j] * rinv * gg * (a + 1.0f) + b;
        v2u o; o.x = pk2(h.x, h.y); o.y = pk2(h.z, h.w); ((v2u*)orow)[64 * j + lane] = o; }
}

#ifndef PHMASK
#define PHMASK 0xffffffffu
#endif
#define IN(k) (lo <= (k) && (k) < hi)
#define EN(j) ((PHMASK >> (j)) & 1u)
#ifndef DUPMASK
#define DUPMASK 0u
#endif
#define NREP(j) (1 + (int)(((DUPMASK >> (j)) & 1u) && l == 0))
#define BOTH(k) (IN(k) && IN((k) + 1))
#define SEAM(k) do { if (BOTH(k)) xcd_barrier(bar); } while (0)
#define HIDE_TID const int lane = lane_fresh(), tid = wave * 64 + lane; (void)lane; (void)tid
struct KCtx {
    LAS unsigned char* lds; unsigned char* ws; const float* in[30]; float* out;
    int tid0, wave, G, bx, gw, NGW, lo, hi;
};
#define KCTX_LOCALS \
    LAS unsigned char* lds = K.lds; unsigned char* ws = K.ws; \
    const int tid0 = K.tid0, wave = K.wave, G = K.G, bx = K.bx, gw = K.gw, NGW = K.NGW, lo = K.lo, hi = K.hi; \
    struct { const float* const* in; float* out; } args{K.in, K.out}; \
    float* MOD = (float*)(ws + WS_MOD); \
    bf16* WTIN = (bf16*)(ws + WS_WTIN); bf16* WTPROJ = (bf16*)(ws + WS_WTPROJ); bf16* WTGU = (bf16*)(ws + WS_WTGU); bf16* WTDN = (bf16*)(ws + WS_WTDN); \
    bf16* H = (bf16*)(ws + WS_H); float* X = (float*)(ws + WS_X); bf16* Y3 = (bf16*)(ws + WS_Y3); float* MF = (float*)(ws + WS_MF); bf16* ODN = (bf16*)(ws + WS_MF); \
    bf16* MB = (bf16*)(ws + WS_MB); bf16* P = (bf16*)(ws + WS_P); bf16* XG = (bf16*)(ws + WS_XG); bf16* ACT = (bf16*)(ws + WS_ACT); bf16* YS = (bf16*)(ws + WS_YS); \
    bf16* QN = (bf16*)(ws + WS_QN); bf16* KN = (bf16*)(ws + WS_KN); bf16* VN = (bf16*)(ws + WS_VN); \
    float* LDEC = (float*)(ws + WS_LDEC); float* BETA = (float*)(ws + WS_BETA); \
    int* TOPI = (int*)(ws + WS_TOPI); float* GATE = (float*)(ws + WS_GATE); int* SLOT = (int*)(ws + WS_SLOT); \
    unsigned* MOEI = (unsigned*)(ws + WS_MOE); unsigned* CNT = (unsigned*)(ws + WS_CNT); unsigned* ctl = (unsigned*)(ws + WS_CTL); int* ROWMAP = (int*)(ws + WS_ROWMAP); (void)ROWMAP; \
    bf16* VTL = (bf16*)(ws + WS_VTL); bf16* VTC = (bf16*)(ws + WS_VTC); (void)ctl; (void)VTL; (void)VTC; \
    unsigned char* TREC = ws + WS_TREC; unsigned char* QKREC = ws + WS_QKREC; float* VEC = (float*)(ws + WS_VEC); (void)TREC; (void)QKREC; (void)VEC; \
    (void)MOD; (void)WTIN; (void)WTPROJ; (void)WTGU; (void)WTDN; (void)H; (void)X; (void)Y3; (void)MF; (void)ODN; (void)MB; (void)P; (void)XG; (void)ACT; (void)YS; (void)QN; (void)KN; (void)VN; \
    (void)LDEC; (void)BETA; (void)TOPI; (void)GATE; (void)SLOT; (void)MOEI; (void)CNT; (void)gw; (void)NGW; (void)wave; (void)G; (void)bx; (void)lds; (void)args
__device__ __forceinline__ void prologue_body(const KCtx& K, const XcdBarrier& bar) {
    KCTX_LOCALS;
    if (EN(0) && IN(0)) { HIDE_TID;
        LAS float* scr = (LAS float*)(lds + wave * 16384);
        constexpr int IT_WIN = 16 * 329, IT_PAD = 7, IT_PROJ = 16 * 32, IT_GU = 16 * 64, IT_DN = 16 * 32;
        constexpr int N_WIN = 2 * IT_WIN, N_PAD = 2 * IT_PAD, N_PROJ = 8 * IT_PROJ, N_GU = 64 * IT_GU, N_DN = 64 * IT_DN;
        (void)N_GU; (void)N_DN;
        for (int it = gw; it < N_PAD; it += NGW) { const int l = it / IT_PAD, pb = it % IT_PAD; bf16* dst = WTIN + (size_t)l * NP * 1024 + (size_t)(2336 + 32 * pb) * 1024;
            for (int i = lane; i < 32 * 1024 / 8; i += 64) ((v4u*)dst)[i] = (v4u){0u, 0u, 0u, 0u}; }
        {
            constexpr int N_CV = N_WIN + N_PROJ;
            f32x4 va[8], vb[8], vc[8]; const float* sp_; int Nn_; bf16 *da, *db, *dc;
#define P0_DECODE(it_, d) do { int r = (it_) < N_CV ? (it_) : N_CV - 1; const int kr = lane >> 3, c4 = lane & 7, n = lane & 31, kh = lane >> 5; \
            if (r < N_WIN) { const int l = r / IT_WIN; r -= l * IT_WIN; const int kb = r / 329, nb = r % 329; const int db_ = nb < 64 ? nb : (nb == 64 ? 72 : (nb < 73 ? nb - 1 : nb + 7)); \
                Nn_ = DIN; sp_ = args.in[I_WIN] + (size_t)l * 1024 * DIN + (size_t)(64 * kb + kr) * DIN + 32 * nb + 4 * c4; d = WTIN + (size_t)l * NP * 1024 + (size_t)(32 * db_ + n) * 1024 + 64 * kb + 8 * kh; } \
            else { r -= N_WIN; const int mi = r / IT_PROJ; r -= mi * IT_PROJ; const int l = mi >> 2, which = mi & 3; const int kb = r / 32, nb = r % 32; \
                const float* wsrc = which == 0 ? args.in[I_WPSG] : (which == 1 ? args.in[I_WPDN] : (which == 2 ? args.in[I_WPAT] : args.in[I_WOUT])); \
                Nn_ = 1024; sp_ = wsrc + (size_t)l * 1024 * 1024 + (size_t)(64 * kb + kr) * 1024 + 32 * nb + 4 * c4; d = WTPROJ + (size_t)mi * 1024 * 1024 + (size_t)(32 * nb + n) * 1024 + 64 * kb + 8 * kh; } } while (0)
#define P0_ISSUE(v, d, it_) do { P0_DECODE(it_, d); _Pragma("unroll") for (int i_ = 0; i_ < 8; ++i_) v[i_] = *(const f32x4*)(sp_ + (size_t)(8 * i_) * Nn_); asm volatile("" ::: "memory"); __builtin_amdgcn_sched_barrier(0); } while (0)
            P0_ISSUE(va, da, gw); P0_ISSUE(vb, db, gw + NGW);
            for (int it = gw; it < N_CV; it += 3 * NGW) {
                P0_ISSUE(vc, dc, it + 2 * NGW);
                cv_proc(va, da, scr, lane);
                if (it + NGW >= N_CV) break;
                P0_ISSUE(va, da, it + 3 * NGW);
                cv_proc(vb, db, scr, lane);
                if (it + 2 * NGW >= N_CV) break;
                P0_ISSUE(vb, db, it + 4 * NGW);
                cv_proc(vc, dc, scr, lane);
            }
#undef P0_ISSUE
#undef P0_DECODE
        }
        for (int it = gw; it < 2 * 512; it += NGW) { const int l = it >> 9, r = it & 511, nb = r >> 4, kb = r & 15;
            transpose_item_small8(args.in[I_WOUT] + (size_t)l * 1024 * 1024, 1024, 64 * kb, 32 * nb, ws + WS_WOUT8 + (size_t)l * 1024 * 1024, 32 * nb, scr, lane); }
        __syncthreads();
        if (bx < 192) {
            LAS float* sc = (LAS float*)lds;
            LAS float* red = (LAS float*)(lds + 9 * 1024 * 4);
            for (int i = tid; i < 9 * 1024; i += 512) { const int s = i >> 10, d = i & 1023; const float cv = s < 8 ? args.in[I_C][s * 1024 + d] : args.in[I_CCTX][d]; sc[i] = siluf_(cv); }
            __syncthreads();
            for (int item = bx; item < 192; item += G) {
                const int l = item / 96, j0 = (item % 96) * 64;
                const int r4 = lane >> 4, c16 = lane & 15;
                const float* wm = args.in[I_WMOD] + (size_t)l * 1024 * 6144 + (size_t)(wave * 128 + r4) * 6144 + j0 + 4 * c16;
                f32x4 a[9];
#pragma unroll
                for (int s = 0; s < 9; ++s) a[s] = (f32x4){0.f, 0.f, 0.f, 0.f};
#pragma unroll 1
                for (int half = 0; half < 2; ++half) {
                    f32x4 wv[16];
#pragma unroll
                    for (int i = 0; i < 16; ++i) wv[i] = *(const f32x4*)(wm + (size_t)(4 * (16 * half + i)) * 6144);
                    asm volatile("" ::: "memory"); __builtin_amdgcn_sched_barrier(0);
#pragma unroll
                    for (int i = 0; i < 16; ++i) { const int d = wave * 128 + 4 * (16 * half + i) + r4;
#pragma unroll
                        for (int s = 0; s < 9; ++s) a[s] += wv[i] * sc[s * 1024 + d]; }
                }
#pragma unroll
                for (int s = 0; s < 9; ++s) {
#pragma unroll
                    for (int k = 0; k < 4; ++k) { float t = a[s][k]; t += __shfl_xor(t, 16); t += __shfl_xor(t, 32); a[s][k] = t; }
                    if (r4 == 0) *(LAS f32x4*)(red + (wave * 9 + s) * 64 + 4 * c16) = a[s]; }
                __syncthreads();
                for (int i = tid; i < 9 * 64; i += 512) { float t = 0.f;
#pragma unroll
                    for (int w = 0; w < 8; ++w) t += red[w * 9 * 64 + i];
                    const int s = i >> 6, j = j0 + (i & 63);
                    MOD[((size_t)l * 9 + s) * 6144 + j] = t + args.in[I_BMOD][l * 6144 + j]; }
                __syncthreads();
            }
        }
    }
    SEAM(0);
    if (EN(1) && IN(1)) { HIDE_TID;
        const int RW1 = (MT + NGW - 1) / NGW, r0 = gw * RW1, r1 = (r0 + RW1) < MT ? (r0 + RW1) : MT;
        if (r0 < r1) {
            f32x4 xv[4], xn[4], gg[4], aa[4], bb[4]; int curslot = -1;
#define P1_ROW(dst, rr) do { const int r_ = (rr) < MT ? (rr) : MT - 1; const float* xr_ = r_ < NL ? args.in[I_X] + (size_t)r_ * D : args.in[I_CTX] + (size_t)(r_ - NL) * D; \
            _Pragma("unroll") for (int j = 0; j < 4; ++j) dst[j] = ((const f32x4*)xr_)[64 * j + lane]; } while (0)
            P1_ROW(xv, r0);
#pragma unroll
            for (int j = 0; j < 4; ++j) gg[j] = ((const f32x4*)args.in[I_NPRE])[64 * j + lane];
            for (int r = r0; r < r1; ++r) {
                P1_ROW(xn, r + 1);
                const int slot = mod_slot(r);
                if (slot != curslot) { curslot = slot; const float* md = MOD + (size_t)slot * 6144;
#pragma unroll
                    for (int j = 0; j < 4; ++j) { bb[j] = ((const f32x4*)md)[64 * j + lane]; aa[j] = ((const f32x4*)(md + 1024))[64 * j + lane]; } }
                asm volatile("" ::: "memory"); __builtin_amdgcn_sched_barrier(0);
                float ss = 0.f;
#pragma unroll
                for (int j = 0; j < 4; ++j) ss += (xv[j].x * xv[j].x + xv[j].y * xv[j].y) + (xv[j].z * xv[j].z + xv[j].w * xv[j].w);
                const float rinv = rsqrtf(wave_sum(ss) * (1.f / D) + EPS);
                bf16* orow = H + (size_t)r * D;
#pragma unroll
                for (int j = 0; j < 4; ++j) { const f32x4 h = xv[j] * rinv * gg[j] * (aa[j] + 1.0f) + bb[j];
                    v2u o; o.x = pk2(h.x, h.y); o.y = pk2(h.z, h.w); ((v2u*)orow)[64 * j + lane] = o; }
#pragma unroll
                for (int j = 0; j < 4; ++j) xv[j] = xn[j];
            }
#undef P1_ROW
        }
    }
    SEAM(1);

}

template <int L> __device__ __forceinline__ void layer_body(const KCtx& K, const XcdBarrier& bar) {
    KCTX_LOCALS;
    constexpr int l = L;
    {
        const int pb = 2 + 12 * l;
        const bool ctx_out = (l == 0);
        const int ML = ctx_out ? MT : NL;
        const float* MODL = MOD + (size_t)l * 9 * 6144;
        if (EN(2) && IN(pb + 0)) for (int rep_ = 0; rep_ < NREP(2); ++rep_) { HIDE_TID;
            pg8::OrderRect2 S; S.A = (const char*)H; S.Bt = (const char*)(WTIN + (size_t)l * NP * 1024); S.G = G; S.c = bx; S.tile = (size_t)256 * 1024 * 2;
            if (ctx_out) { S.nM0 = MT / 256; S.nN0 = NP / 256; S.nM1 = 0; S.nN1 = 0; } else { S.nM0 = NL / 256; S.nN0 = NP / 256; S.nM1 = NC / 256; S.nN1 = 10; }
            pg8::EpiStoreBf16 E{P, NP};
            pg8::gemm_phase<pg8::EpiStoreBf16, pg8::OrderRect2>(lds, S, E, wave);
        }
        SEAM(pb + 0);
        if (EN(3) && IN(pb + 1)) for (int rep_ = 0; rep_ < NREP(3); ++rep_) { HIDE_TID;
            LAS float* rtab = (LAS float*)lds;
            LAS float* cwl = (LAS float*)(lds + 8192);
            { const float* convw = args.in[I_CONVW] + (size_t)l * 5 * 3072;
              for (int i = tid; i < 1024; i += 512) { const int pos = i >> 4, fi = i & 15; float sn, cs; sincosf((float)pos * exp2f(-(float)fi * (13.287712379549449f / 16.0f)), &sn, &cs); rtab[2 * i] = cs; rtab[2 * i + 1] = sn; }
              for (int i = tid; i < 5 * 3072 / 4; i += 512) *(LAS f32x4*)(cwl + 4 * i) = *(const f32x4*)(convw + 4 * i); }
            __syncthreads();
            const int RW = (MT + NGW - 1) / NGW, rw0 = gw * RW, rw1 = (rw0 + RW) < MT ? (rw0 + RW) : MT;
#pragma unroll 1
            for (int part = 0; part < 3; ++part) {
                const int ccol = (part == 0 ? C_DNQ : (part == 1 ? C_DNK : C_DNV)) + 16 * lane;
                bf16* dbase = (part == 0 ? QN : (part == 1 ? KN : VN)) + 16 * lane;
                const LAS float* wp = cwl + part * 1024 + 16 * lane;
                v4u wa[6], wb[6];
#define B_LDROW(slot, rr) do { const int rc_ = (rr) < 0 ? 0 : ((rr) >= MT ? MT - 1 : (rr)); const bf16* src_ = P + (size_t)rc_ * NP + ccol; wa[slot] = *(const v4u*)src_; wb[slot] = *(const v4u*)(src_ + 8); } while (0)
                if (rw0 < rw1) { B_LDROW(0, rw0 - 2); B_LDROW(1, rw0 - 1); B_LDROW(2, rw0); B_LDROW(3, rw0 + 1); B_LDROW(4, rw0 + 2); }
#pragma unroll 1
                for (int r = rw0; r < rw1; ++r) {
                    asm volatile("" ::: "memory");
                    B_LDROW(5, r + 3);
                    asm volatile("" ::: "memory");
                    const bool is_lat = r < NL; const bool full = is_lat || ctx_out;
                    const int b = row_batch(r), t = is_lat ? r - b * SEQ : (r - NL) - b * CTXL, slen = is_lat ? SEQ : CTXL;
                    float y[16];
#pragma unroll
                    for (int i = 0; i < 16; ++i) y[i] = 0.f;
#pragma unroll
                    for (int tap = 0; tap < 5; ++tap) { const int tt = t + tap - 2;
                        if (tt >= 0 && tt < slen) { const v4u xa = wa[tap], xb = wb[tap];
                            const float xv[16] = {bflo(xa.x), bfhi(xa.x), bflo(xa.y), bfhi(xa.y), bflo(xa.z), bfhi(xa.z), bflo(xa.w), bfhi(xa.w), bflo(xb.x), bfhi(xb.x), bflo(xb.y), bfhi(xb.y), bflo(xb.z), bfhi(xb.z), bflo(xb.w), bfhi(xb.w)};
#pragma unroll
                            for (int i4 = 0; i4 < 4; ++i4) { const f32x4 w4 = *(const LAS f32x4*)(wp + tap * 3072 + 4 * i4);
                                y[4 * i4 + 0] += xv[4 * i4 + 0] * w4.x; y[4 * i4 + 1] += xv[4 * i4 + 1] * w4.y; y[4 * i4 + 2] += xv[4 * i4 + 2] * w4.z; y[4 * i4 + 3] += xv[4 * i4 + 3] * w4.w; } } }
                    float ss = 0.f;
#pragma unroll
                    for (int i = 0; i < 16; ++i) { y[i] = siluf_(y[i]); ss += y[i] * y[i]; }
                    if (part < 2) { ss += __shfl_xor(ss, 1); ss += __shfl_xor(ss, 2); ss += __shfl_xor(ss, 4);
                        const float sc = rsqrtf(ss + EPS) * (part == 0 ? 0.08838834764831845f : 1.0f);
#pragma unroll
                        for (int i = 0; i < 16; ++i) y[i] *= sc; }
                    if (part != 0 || full) st16(dbase + (size_t)r * D, y);
#pragma unroll
                    for (int k = 0; k < 5; ++k) { wa[k] = wa[k + 1]; wb[k] = wb[k + 1]; }
                }
#undef B_LDROW
            }
            {
                float lgv[16], lbv[16];
#pragma unroll
                for (int i4 = 0; i4 < 4; ++i4) { const f32x4 a4 = *(const f32x4*)(args.in[I_SGLNG] + l * 1024 + 16 * lane + 4 * i4), b4 = *(const f32x4*)(args.in[I_SGLNB] + l * 1024 + 16 * lane + 4 * i4);
                    lgv[4 * i4] = a4.x; lgv[4 * i4 + 1] = a4.y; lgv[4 * i4 + 2] = a4.z; lgv[4 * i4 + 3] = a4.w; lbv[4 * i4] = b4.x; lbv[4 * i4 + 1] = b4.y; lbv[4 * i4 + 2] = b4.z; lbv[4 * i4 + 3] = b4.w; }
                const float alog_dtb0 = args.in[I_ALOG][l * 16 + (lane & 15)], alog_dtb1 = args.in[I_DTB][l * 16 + (lane & 15)];
                v4u nq[2], nk[2], nu[2], nv[2], ng[6]; unsigned nab;
#define B_RAW(rr) do { const int rc_ = (rr) < MT ? (rr) : MT - 1; const bf16* p_ = P + (size_t)rc_ * NP; \
                    nq[0] = *(const v4u*)(p_ + C_ATQ + 16 * lane); nq[1] = *(const v4u*)(p_ + C_ATQ + 16 * lane + 8); nk[0] = *(const v4u*)(p_ + C_ATK + 16 * (lane & 7)); nk[1] = *(const v4u*)(p_ + C_ATK + 16 * (lane & 7) + 8); \
                    nu[0] = *(const v4u*)(p_ + C_SGU + 16 * lane); nu[1] = *(const v4u*)(p_ + C_SGU + 16 * lane + 8); nv[0] = *(const v4u*)(p_ + C_SGV + 16 * lane); nv[1] = *(const v4u*)(p_ + C_SGV + 16 * lane + 8); \
                    nab = p_[C_DNA + (lane & 31)]; \
                    _Pragma("unroll") for (int g_ = 0; g_ < 3; ++g_) { ng[2 * g_] = *(const v4u*)(p_ + C_GATE + 1024 * g_ + 16 * lane); ng[2 * g_ + 1] = *(const v4u*)(p_ + C_GATE + 1024 * g_ + 16 * lane + 8); } } while (0)
#define B_UNPK(f, a_, b_) do { f[0] = bflo(a_.x); f[1] = bfhi(a_.x); f[2] = bflo(a_.y); f[3] = bfhi(a_.y); f[4] = bflo(a_.z); f[5] = bfhi(a_.z); f[6] = bflo(a_.w); f[7] = bfhi(a_.w); \
                    f[8] = bflo(b_.x); f[9] = bfhi(b_.x); f[10] = bflo(b_.y); f[11] = bfhi(b_.y); f[12] = bflo(b_.z); f[13] = bfhi(b_.z); f[14] = bflo(b_.w); f[15] = bfhi(b_.w); } while (0)
                if (rw0 < rw1) B_RAW(rw0);
                for (int r = rw0; r < rw1; ++r) {
                    const bool is_lat = r < NL; const bool full = is_lat || ctx_out;
                    const int b = row_batch(r), t = is_lat ? r - b * SEQ : (r - NL) - b * CTXL;
                    bf16* pr = P + (size_t)r * NP;
                    const v4u cq0 = nq[0], cq1 = nq[1], ck0 = nk[0], ck1 = nk[1], cu0 = nu[0], cu1 = nu[1], cv0 = nv[0], cv1 = nv[1], cg0 = ng[0], cg1 = ng[1], cg2 = ng[2], cg3 = ng[3], cg4 = ng[4], cg5 = ng[5]; const unsigned cab = nab;
                    asm volatile("" ::: "memory");
                    B_RAW(r + 1);
                    asm volatile("" ::: "memory");
                    if (is_lat) {
                        const int pos = ((lane & 3) < 2) ? (t >> 6) : (t & 63);
                        float cs[16], sn[16];
#pragma unroll
                        for (int i2 = 0; i2 < 8; ++i2) { const f32x4 t4 = *(const LAS f32x4*)(rtab + pos * 32 + 4 * i2); cs[2 * i2] = t4.x; sn[2 * i2] = t4.y; cs[2 * i2 + 1] = t4.z; sn[2 * i2 + 1] = t4.w; }
                        const float sgn = (lane & 1) ? 1.0f : -1.0f;
                        { float q[16], qp[16]; B_UNPK(q, cq0, cq1);
#pragma unroll
                          for (int i = 0; i < 16; ++i) qp[i] = __shfl_xor(q[i], 1);
#pragma unroll
                          for (int i = 0; i < 16; ++i) q[i] = (q[i] * cs[i] + sgn * qp[i] * sn[i]) * 0.125f;
                          st16(pr + C_ATQ + 16 * lane, q); }
                        { float k[16], kp[16]; B_UNPK(k, ck0, ck1);
#pragma unroll
                          for (int i = 0; i < 16; ++i) kp[i] = __shfl_xor(k[i], 1);
#pragma unroll
                          for (int i = 0; i < 16; ++i) k[i] = k[i] * cs[i] + sgn * kp[i] * sn[i];
                          if (lane < 8) st16(pr + C_ATK + 16 * lane, k); }
                    } else if (full) {
                        float q[16]; B_UNPK(q, cq0, cq1);
#pragma unroll
                        for (int i = 0; i < 16; ++i) q[i] *= 0.125f;
                        st16(pr + C_ATQ + 16 * lane, q);
                    }
                    if (lane < 16) LDEC[(size_t)r * 16 + lane] = -fexp(alog_dtb0) * softplusf_(bf1((bf16)cab) + alog_dtb1);
                    else if (lane < 32) BETA[(size_t)r * 16 + lane - 16] = sigmoidf_(bf1((bf16)cab));
                    if (full) {
                        float u[16]; B_UNPK(u, cu0, cu1);
#pragma unroll
                        for (int i = 0; i < 16; ++i) u[i] = gelu_tanh(u[i]);
                        st16(pr + C_SGU + 16 * lane, u);
                        float v[16]; B_UNPK(v, cv0, cv1); float s = 0.f;
#pragma unroll
                        for (int i = 0; i < 16; ++i) { v[i] = gelu_tanh(v[i]); s += v[i]; }
                        const float mean = wave_sum(s) * (1.f / 1024.f); float s2 = 0.f;
#pragma unroll
                        for (int i = 0; i < 16; ++i) { v[i] -= mean; s2 += v[i] * v[i]; }
                        const float rstd = rsqrtf(wave_sum(s2) * (1.f / 1024.f) + EPS);
#pragma unroll
                        for (int i = 0; i < 16; ++i) v[i] = v[i] * rstd * lgv[i] + lbv[i];
                        st16(pr + C_SGV + 16 * lane, v);
                        { float x0[16], x1[16], x2[16]; B_UNPK(x0, cg0, cg1); B_UNPK(x1, cg2, cg3); B_UNPK(x2, cg4, cg5);
#pragma unroll
                          for (int i = 0; i < 16; ++i) { const float e0 = 1.0f + fexp(-__builtin_amdgcn_fmed3f(x0[i], -30.0f, 30.0f)), e1 = 1.0f + fexp(-__builtin_amdgcn_fmed3f(x1[i], -30.0f, 30.0f)), e2 = 1.0f + fexp(-__builtin_amdgcn_fmed3f(x2[i], -30.0f, 30.0f));
                              x0[i] = e1 * frcp(e0); x1[i] = e2 * frcp(e1); x2[i] = frcp(e2); }
                          st16(pr + C_GATE + 16 * lane, x0); st16(pr + C_GATE + 1024 + 16 * lane, x1); st16(pr + C_GATE + 2048 + 16 * lane, x2); }
                    }
                }
#undef B_RAW
#undef B_UNPK
            }
            for (int it = gw; it < (MT / 64) * 2; it += NGW) {
                const int kvh = it & 1, row0 = (it >> 1) * 64; const bool is_lat = row0 < NL;
                const int b = row_batch(row0), t0 = is_lat ? row0 - b * SEQ : (row0 - NL) - b * CTXL;
                const v4u* src = (const v4u*)(P + (size_t)(row0 + lane) * NP + C_ATV + kvh * 64);
                bf16* dst = is_lat ? VTL + ((size_t)(b * 2 + kvh) * 64) * SEQ + t0 + lane : VTC + ((size_t)(b * 2 + kvh) * 64) * CTXL + t0 + lane;
                const int pitch = is_lat ? SEQ : CTXL;
                v4u wj[8];
#pragma unroll
                for (int j = 0; j < 8; ++j) wj[j] = src[j];
                asm volatile("" ::: "memory");
#pragma unroll
                for (int j = 0; j < 8; ++j) { const v4u w = wj[j];
                    dst[(size_t)(8 * j + 0) * pitch] = (bf16)(w.x & 0xffffu); dst[(size_t)(8 * j + 1) * pitch] = (bf16)(w.x >> 16);
                    dst[(size_t)(8 * j + 2) * pitch] = (bf16)(w.y & 0xffffu); dst[(size_t)(8 * j + 3) * pitch] = (bf16)(w.y >> 16);
                    dst[(size_t)(8 * j + 4) * pitch] = (bf16)(w.z & 0xffffu); dst[(size_t)(8 * j + 5) * pitch] = (bf16)(w.z >> 16);
                    dst[(size_t)(8 * j + 6) * pitch] = (bf16)(w.w & 0xffffu); dst[(size_t)(8 * j + 7) * pitch] = (bf16)(w.w >> 16); }
            }
        }
        SEAM(pb + 1);
        if (EN(4) && IN(pb + 2)) for (int rep_ = 0; rep_ < NREP(4); ++rep_) { HIDE_TID;
            {
                LAS float* At = (LAS float*)(lds + (wave & 3) * 32768);
                LAS float* Yl = At + 4096;
                LAS float* gamL = (LAS float*)(lds + MISC_OFF + 4096 + wave * 512);
                LAS float* betL = gamL + 64;
                const int r31 = lane & 31, hh = lane >> 5;
                bf16x8 Kf[2][8], Qf[2][8]; float gam_ld = 0.f, bet_ld = 0.f;
#define DN_LOAD(itx) do { const int it_ = (itx) < DN_ITEMS ? (itx) : DN_ITEMS - 1; const int c_ = it_ % DN_NCH, u_ = it_ / DN_NCH, dir_ = u_ & 1, h_ = (u_ >> 1) & 7, b_ = u_ >> 4; \
        { const int ri_ = dn_row(b_, dir_, c_, lane); gam_ld = LDEC[(size_t)ri_ * 16 + dir_ * 8 + h_]; bet_ld = BETA[(size_t)ri_ * 16 + dir_ * 8 + h_]; } \
        _Pragma("unroll") for (int a_ = 0; a_ < 2; ++a_) { const size_t ro_ = (size_t)dn_row(b_, dir_, c_, 32 * a_ + r31) * D + h_ * 128 + 8 * hh; \
            _Pragma("unroll") for (int ks_ = 0; ks_ < 8; ++ks_) { Kf[a_][ks_] = *(const bf16x8*)(KN + ro_ + 16 * ks_); Qf[a_][ks_] = *(const bf16x8*)(QN + ro_ + 16 * ks_); } } \
        asm volatile("" ::: "memory"); __builtin_amdgcn_sched_barrier(0); } while (0)
                if (wave < 4 && bx * 4 + wave < DN_ITEMS) DN_LOAD(bx * 4 + wave);
                if (wave < 4) for (int it = bx * 4 + wave; it < DN_ITEMS; it += G * 4) {
                    const int c = it % DN_NCH, u = it / DN_NCH, dir = u & 1, h = (u >> 1) & 7, b = u >> 4; (void)c; (void)dir; (void)h; (void)b;
                    float gam = gam_ld, bet = bet_ld;
#pragma unroll
                    for (int o = 1; o < 64; o <<= 1) { const float t = __shfl_up(gam, o); if (lane >= o) gam += t; }
                    const float g63 = __shfl(gam, 63);
                    gamL[lane] = gam; betL[lane] = bet;
                    { float* vr = VEC + (size_t)it * 256; vr[lane] = fexp(gam); vr[64 + lane] = bet; vr[128 + lane] = fexp(g63 - gam); if (lane == 0) vr[192] = fexp(g63); }
                    LDS_WAIT();
#pragma unroll
                    for (int tt = 0; tt < 3; ++tt) { const int a = tt == 2 ? 1 : 0, bq = tt == 0 ? 0 : 1;
                        f32x16 acc;
#pragma unroll
                        for (int i = 0; i < 16; ++i) acc[i] = 0.f;
#pragma unroll
                        for (int ks = 0; ks < 8; ++ks) acc = MFMA32(Kf[a][ks], Kf[bq][ks], acc);
                        const int j = 32 * bq + r31; const float gj = gamL[j], bj = betL[j];
#pragma unroll
                        for (int g4 = 0; g4 < 4; ++g4) { const int i0 = 32 * a + 8 * g4 + 4 * hh; const f32x4 gi = *(const LAS f32x4*)(gamL + i0);
#pragma unroll
                            for (int e = 0; e < 4; ++e) { const int i = i0 + e; At[i * 64 + j] = (j > i) ? bj * fexp(gj - gi[e]) * acc[4 * g4 + e] : 0.f; } }
                        asm volatile("" ::: "memory"); }
                    asm volatile("" ::: "memory");
                    {
#pragma unroll
                        for (int tt = 0; tt < 3; ++tt) { const int jt = tt == 2 ? 1 : 0, iq = tt == 0 ? 0 : 1;
                            f32x16 acc;
#pragma unroll
                            for (int i = 0; i < 16; ++i) acc[i] = 0.f;
#pragma unroll
                            for (int ks = 0; ks < 8; ++ks) acc = MFMA32(Kf[jt][ks], Qf[iq][ks], acc);
                            const int i = 32 * iq + r31; const float gi = gamL[i];
#pragma unroll
                            for (int g4 = 0; g4 < 4; ++g4) { const int j0 = 32 * jt + 8 * g4 + 4 * hh; const f32x4 gj = *(const LAS f32x4*)(gamL + j0);
#pragma unroll
                                for (int e = 0; e < 4; ++e) { const int j = j0 + e; acc[4 * g4 + e] = (i >= j) ? fexp(gi - gj[e]) * acc[4 * g4 + e] : 0.f; } }
#pragma unroll
                            for (int sq = 0; sq < 2; ++sq) { const bf16x8 f = pack_frag(acc, sq);
                                *(bf16x8*)(QKREC + (size_t)it * 6144 + (tt * 2 + sq) * 1024 + lane * 16) = f; }
                            asm volatile("" ::: "memory"); }
                    }
                    LDS_WAIT();
                    DN_LOAD(it + G * 4);
                    {
                        const int rb = 32 * hh;
                        { LAS float* z = Yl + (32 + (lane >> 1)) * 64 + 16 * (lane & 1);
                          const f32x4 z4 = (f32x4){0.f, 0.f, 0.f, 0.f}; *(LAS f32x4*)z = z4; *(LAS f32x4*)(z + 4) = z4; *(LAS f32x4*)(z + 8) = z4; *(LAS f32x4*)(z + 12) = z4; }
#pragma unroll 1
                        for (int ib = 7; ib >= 0; --ib) {
                            float y0 = (r31 == 4 * ib) ? 1.0f : 0.0f, y1 = (r31 == 4 * ib + 1) ? 1.0f : 0.0f, y2 = (r31 == 4 * ib + 2) ? 1.0f : 0.0f, y3 = (r31 == 4 * ib + 3) ? 1.0f : 0.0f;
                            const LAS float* ar = At + (rb + 4 * ib) * 64 + rb;
#pragma unroll 2
                            for (int jg = ib + 1; jg < 8; ++jg) { const LAS float* yp = Yl + (rb + 4 * jg) * 64 + lane; const float q0 = yp[0], q1 = yp[64], q2 = yp[128], q3 = yp[192];
                                const f32x4 c0 = *(const LAS f32x4*)(ar + 4 * jg), c1 = *(const LAS f32x4*)(ar + 64 + 4 * jg), c2 = *(const LAS f32x4*)(ar + 128 + 4 * jg), c3 = *(const LAS f32x4*)(ar + 192 + 4 * jg);
                                y0 -= c0.x * q0 + c0.y * q1 + c0.z * q2 + c0.w * q3; y1 -= c1.x * q0 + c1.y * q1 + c1.z * q2 + c1.w * q3;
                                y2 -= c2.x * q0 + c2.y * q1 + c2.z * q2 + c2.w * q3; y3 -= c3.x * q0 + c3.y * q1 + c3.z * q2 + c3.w * q3; }
                            { const f32x4 d0 = *(const LAS f32x4*)(ar + 4 * ib), d1 = *(const LAS f32x4*)(ar + 64 + 4 * ib), d2 = *(const LAS f32x4*)(ar + 128 + 4 * ib);
                              y2 -= d2.w * y3; y1 -= d1.z * y2 + d1.w * y3; y0 -= d0.y * y1 + d0.z * y2 + d0.w * y3; }
                            LAS float* yo = Yl + (rb + 4 * ib) * 64 + lane; yo[0] = y0; yo[64] = y1; yo[128] = y2; yo[192] = y3;
                        }
                        asm volatile("" ::: "memory");
                        f32x16 wacc;
#pragma unroll
                        for (int i = 0; i < 16; ++i) wacc[i] = 0.f;
#pragma unroll
                        for (int sq = 0; sq < 2; ++sq) {
                            const LAS float* ua = At + r31 * 64 + 32 + 16 * sq + 8 * hh; const f32x4 u0 = *(const LAS f32x4*)ua, u1 = *(const LAS f32x4*)(ua + 4);
                            const LAS float* yb = Yl + (32 + 16 * sq + 8 * hh) * 64 + 32 + r31;
                            v4u pa, pb; pa.x = pk2(u0.x, u0.y); pa.y = pk2(u0.z, u0.w); pa.z = pk2(u1.x, u1.y); pa.w = pk2(u1.z, u1.w);
                            pb.x = pk2(yb[0], yb[64]); pb.y = pk2(yb[128], yb[192]); pb.z = pk2(yb[256], yb[320]); pb.w = pk2(yb[384], yb[448]);
                            wacc = MFMA32(__builtin_bit_cast(bf16x8, pa), __builtin_bit_cast(bf16x8, pb), wacc); }
                        f32x16 yacc;
#pragma unroll
                        for (int i = 0; i < 16; ++i) yacc[i] = 0.f;
#pragma unroll
                        for (int sq = 0; sq < 2; ++sq) {
                            const LAS float* ya = Yl + r31 * 64 + 16 * sq + 4 * hh; const f32x4 a0 = *(const LAS f32x4*)ya, a1 = *(const LAS f32x4*)(ya + 8);
                            v4u pa; pa.x = pk2(a0.x, a0.y); pa.y = pk2(a0.z, a0.w); pa.z = pk2(a1.x, a1.y); pa.w = pk2(a1.z, a1.w);
                            const bf16x8 wf = pack_frag(wacc, sq);
                            yacc = MFMA32(__builtin_bit_cast(bf16x8, pa), wf, yacc); }
#pragma unroll
                        for (int g4 = 0; g4 < 4; ++g4)
#pragma unroll
                            for (int e = 0; e < 4; ++e) Yl[(8 * g4 + 4 * hh + e) * 64 + 32 + r31] = -yacc[4 * g4 + e];
                        asm volatile("" ::: "memory");
                    }
                    { LAS unsigned char* Tl = (LAS unsigned char*)At + lane * 144;
#pragma unroll 2
                      for (int q8 = 0; q8 < 8; ++q8) { const LAS float* yp = Yl + (8 * q8) * 64 + lane;
                          v4u w; w.x = pk2(yp[0], yp[64]); w.y = pk2(yp[128], yp[192]); w.z = pk2(yp[256], yp[320]); w.w = pk2(yp[384], yp[448]);
                          *(LAS v4u*)(Tl + 16 * q8) = w; } }
                    LDS_WAIT();
#pragma unroll
                    for (int f = 0; f < 6; ++f) { const int mt = f < 2 ? 0 : 1, ks = f < 2 ? f : f - 2;
                        const LAS unsigned char* src = (const LAS unsigned char*)At + (32 * mt + r31) * 144 + 2 * (32 * (ks >> 1) + 16 * (ks & 1) + 4 * hh);
                        const v2u lo = *(const LAS v2u*)src, hi = *(const LAS v2u*)(src + 16);
                        *(v4u*)(TREC + (size_t)it * 6144 + f * 1024 + lane * 16) = (v4u){lo.x, lo.y, hi.x, hi.y}; }
                    LDS_WAIT();
                }
#undef DN_LOAD
                {
                    LAS float* scr = wave < 4 ? (LAS float*)(lds + wave * 32768) : (LAS float*)(lds + MISC_OFF + 6144) + (wave - 4) * 544;
                    LAS unsigned* cvq = (LAS unsigned*)(lds + MISC_OFF + 448);
                    const int cv_rem = (ML / 256 * 4) % G, cv_short = cv_rem ? G - cv_rem : 0, cv_n1 = CV_N_TOT - (CV_E_QUOTA + CV_F_QUOTA) * 8 * cv_short;
                    for (;;) { unsigned m = 0; if (lane == 0) m = atomicAdd((unsigned*)cvq, 1u); m = (unsigned)__builtin_amdgcn_readfirstlane((int)m);
                        const int it = bx + G * (int)m; if (it >= cv_n1) break;
                        expert_item(it, l, args.in[I_WGU], args.in[I_WDN], WTGU, WTDN, scr, lane); }
                }
            }
            __syncthreads();
            if (tid == 0) *(LAS unsigned*)(lds + MISC_OFF + 448) = 0u;
            __syncthreads();
        }
        SEAM(pb + 2);
        if (EN(5) && IN(pb + 3)) for (int rep_ = 0; rep_ < NREP(5); ++rep_) { HIDE_TID;
            for (int unit = bx; unit < 128; unit += G) {
                const int b = unit >> 4, h = (unit >> 1) & 7, dir = unit & 1;
                constexpr int BUF = 63488, O_K = 0, O_Q = 16384, O_T = 32768, O_QK = 38912, O_VEC = 45056, O_V = 46080, VP = 272;
                const size_t item0 = (size_t)unit * DN_NCH;
                __syncthreads();
                if (wave >= 4) {
                    const int lt = lane_fresh() + 64 * (wave - 4);
                    v4u kv[4], qv[4], rv[4], wv[4];
#define DN_PIECE(k4) const int p = lt + 256 * (k4), i = 16 * ((p >> 6) & 3) + (p & 15), q = 4 * (p >> 8) + ((p >> 4) & 3)
#define DN_LOAD(cc) do { _Pragma("unroll") for (int k4 = 0; k4 < 4; ++k4) { DN_PIECE(k4); const size_t ro = (size_t)dn_row(b, dir, (cc), i) * D + h * 128 + 8 * q; \
                            kv[k4] = *(const v4u*)(KN + ro); qv[k4] = *(const v4u*)(QN + ro); wv[k4] = *(const v4u*)(VN + ro); \
                            const int pr = lt + 256 * k4; const unsigned char* rs = pr < 384 ? TREC + (item0 + (cc)) * 6144 + pr * 16 : (pr < 768 ? QKREC + (item0 + (cc)) * 6144 + (pr - 384) * 16 : (const unsigned char*)(VEC + (item0 + (cc)) * 256) + (pr - 768) * 16); \
                            if (pr < 832) rv[k4] = *(const v4u*)rs; } } while (0)
#define DN_WRITE(bufp) do { _Pragma("unroll") for (int k4 = 0; k4 < 4; ++k4) { DN_PIECE(k4); \
                            { const int mt = i >> 5, r = i & 31, ks = q >> 1; LAS unsigned char* d0 = (bufp) + ((mt * 8 + ks) * 64 + r) * 16 + 8 * (q & 1); \
                              *(LAS v2u*)(d0 + O_K) = (v2u){kv[k4].x, kv[k4].y}; *(LAS v2u*)(d0 + O_K + 512) = (v2u){kv[k4].z, kv[k4].w}; \
                              *(LAS v2u*)(d0 + O_Q) = (v2u){qv[k4].x, qv[k4].y}; *(LAS v2u*)(d0 + O_Q + 512) = (v2u){qv[k4].z, qv[k4].w}; \
                              *(LAS v4u*)((bufp) + O_V + i * VP + 16 * q) = wv[k4]; } \
                            const int pr = lt + 256 * k4; if (pr < 832) *(LAS v4u*)((bufp) + O_T + pr * 16) = rv[k4]; } } while (0)
                    DN_LOAD(0); DN_WRITE(lds); DN_LOAD(1); LDS_WAIT();
                    __builtin_amdgcn_s_barrier(); asm volatile("" ::: "memory");
                    for (int c = 0; c < DN_NCH; ++c) {
                        if (c + 1 < DN_NCH) { DN_WRITE(lds + ((c + 1) & 1) * BUF); }
                        if (c + 2 < DN_NCH) { DN_LOAD(c + 2); }
                        LDS_WAIT();
                        __builtin_amdgcn_s_barrier(); asm volatile("" ::: "memory");
                    }
#undef DN_LOAD
#undef DN_WRITE
#undef DN_PIECE
                } else {
                    const int n = wave;
                    f32x16 S[4];
#pragma unroll
                    for (int kt = 0; kt < 4; ++kt)
#pragma unroll
                        for (int i = 0; i < 16; ++i) S[kt][i] = 0.f;
                    __builtin_amdgcn_s_barrier(); asm volatile("" ::: "memory");
                    for (int c = 0; c < DN_NCH; ++c) {
                        const int lane = lane_fresh(), r31 = lane & 31, hh = lane >> 5;
                        const LAS unsigned char* buf = lds + (c & 1) * BUF;
                        const unsigned fba = (unsigned)(size_t)buf + (unsigned)(lane * 16);
                        const bool want_o = (c >= 4) || ctx_out;
                        unsigned vv[16];
                        { const unsigned va = (unsigned)(size_t)(buf + O_V) + (unsigned)(4 * hh * VP + (32 * n + r31) * 2);
                          unsigned vl[16], vh[16];
#define VO(i) (((i) & 3) + 8 * ((i) >> 2)) * 272
#define VRD16(arr, base) asm volatile("ds_read_u16 %0, %16 offset:%17\n\tds_read_u16 %1, %16 offset:%18\n\tds_read_u16 %2, %16 offset:%19\n\tds_read_u16 %3, %16 offset:%20\n\t" \
                                       "ds_read_u16 %4, %16 offset:%21\n\tds_read_u16 %5, %16 offset:%22\n\tds_read_u16 %6, %16 offset:%23\n\tds_read_u16 %7, %16 offset:%24\n\t" \
                                       "ds_read_u16 %8, %16 offset:%25\n\tds_read_u16 %9, %16 offset:%26\n\tds_read_u16 %10, %16 offset:%27\n\tds_read_u16 %11, %16 offset:%28\n\t" \
                                       "ds_read_u16 %12, %16 offset:%29\n\tds_read_u16 %13, %16 offset:%30\n\tds_read_u16 %14, %16 offset:%31\n\tds_read_u16 %15, %16 offset:%32\n\ts_waitcnt lgkmcnt(0)" \
                                       : "=&v"(arr[0]), "=&v"(arr[1]), "=&v"(arr[2]), "=&v"(arr[3]), "=&v"(arr[4]), "=&v"(arr[5]), "=&v"(arr[6]), "=&v"(arr[7]), "=&v"(arr[8]), "=&v"(arr[9]), "=&v"(arr[10]), "=&v"(arr[11]), "=&v"(arr[12]), "=&v"(arr[13]), "=&v"(arr[14]), "=&v"(arr[15]) \
                                       : "v"(va), "n"(VO(0) + (base)), "n"(VO(1) + (base)), "n"(VO(2) + (base)), "n"(VO(3) + (base)), "n"(VO(4) + (base)), "n"(VO(5) + (base)), "n"(VO(6) + (base)), "n"(VO(7) + (base)), \
                                         "n"(VO(8) + (base)), "n"(VO(9) + (base)), "n"(VO(10) + (base)), "n"(VO(11) + (base)), "n"(VO(12) + (base)), "n"(VO(13) + (base)), "n"(VO(14) + (base)), "n"(VO(15) + (base)) : "memory")
                          VRD16(vl, 0); VRD16(vh, 32 * 272);
#undef VRD16
#undef VO
#pragma unroll
                          for (int i = 0; i < 16; ++i) vv[i] = vl[i] | (vh[i] << 16);
                        }
                        const LAS float* vec = (const LAS float*)(buf + O_VEC);
                        bf16x8 Sf[8];
#pragma unroll
                        for (int kt = 0; kt < 4; ++kt) { Sf[2 * kt] = pack_frag(S[kt], 0); Sf[2 * kt + 1] = pack_frag(S[kt], 1); }
                        asm volatile("" ::: "memory");
                        f32x16 X[2];
#pragma unroll
                        for (int mt = 0; mt < 2; ++mt) {
#pragma unroll
                            for (int i = 0; i < 16; ++i) X[mt][i] = 0.f;
                            { bf16x8 af[8]; if (mt == 0) LDFRAG8(af, fba, O_K); else LDFRAG8(af, fba, O_K + 8192);
#pragma unroll
                              for (int ks = 0; ks < 8; ++ks) X[mt] = MFMA32(af[ks], Sf[ks], X[mt]); } }
#pragma unroll
                        for (int mt = 0; mt < 2; ++mt)
#pragma unroll
                            for (int g4 = 0; g4 < 4; ++g4) { const int i0 = 32 * mt + 8 * g4 + 4 * hh; const f32x4 eg = *(const LAS f32x4*)(vec + i0), bt = *(const LAS f32x4*)(vec + 64 + i0);
#pragma unroll
                                for (int e = 0; e < 4; ++e) { const float vval = mt == 0 ? bflo(vv[4 * g4 + e]) : bfhi(vv[4 * g4 + e]); X[mt][4 * g4 + e] = bt[e] * (vval - eg[e] * X[mt][4 * g4 + e]); } }
                        asm volatile("" ::: "memory");
                        bf16x8 Rf[4];
#pragma unroll
                        for (int mt = 0; mt < 2; ++mt) { Rf[2 * mt] = pack_frag(X[mt], 0); Rf[2 * mt + 1] = pack_frag(X[mt], 1); }
                        f32x16 U[2];
#pragma unroll
                        for (int mt = 0; mt < 2; ++mt)
#pragma unroll
                            for (int i = 0; i < 16; ++i) U[mt][i] = 0.f;
                        { bf16x8 tf[6]; LDFRAG6(tf, fba, O_T);
                          U[0] = MFMA32(tf[0], Rf[0], U[0]); U[1] = MFMA32(tf[2], Rf[0], U[1]); U[0] = MFMA32(tf[1], Rf[1], U[0]); U[1] = MFMA32(tf[3], Rf[1], U[1]);
                          U[1] = MFMA32(tf[4], Rf[2], U[1]); U[1] = MFMA32(tf[5], Rf[3], U[1]); }
                        asm volatile("" ::: "memory");
                        bf16x8 Uf[4], Ue[4];
#pragma unroll
                        for (int mt = 0; mt < 2; ++mt) { Uf[2 * mt] = pack_frag(U[mt], 0); Uf[2 * mt + 1] = pack_frag(U[mt], 1); }
#pragma unroll
                        for (int mt = 0; mt < 2; ++mt)
#pragma unroll
                            for (int g4 = 0; g4 < 4; ++g4) { const int i0 = 32 * mt + 8 * g4 + 4 * hh; const f32x4 ee = *(const LAS f32x4*)(vec + 128 + i0);
#pragma unroll
                                for (int e = 0; e < 4; ++e) U[mt][4 * g4 + e] *= ee[e]; }
#pragma unroll
                        for (int mt = 0; mt < 2; ++mt) { Ue[2 * mt] = pack_frag(U[mt], 0); Ue[2 * mt + 1] = pack_frag(U[mt], 1); }
                        asm volatile("" ::: "memory");
                        if (want_o) {
#pragma unroll
                            for (int mt = 0; mt < 2; ++mt) {
                                f32x16 Oa;
#pragma unroll
                                for (int i = 0; i < 16; ++i) Oa[i] = 0.f;
                                { bf16x8 af[8]; if (mt == 0) LDFRAG8(af, fba, O_Q); else LDFRAG8(af, fba, O_Q + 8192);
#pragma unroll
                                  for (int ks = 0; ks < 8; ++ks) Oa = MFMA32(af[ks], Sf[ks], Oa); }
#pragma unroll
                                for (int g4 = 0; g4 < 4; ++g4) { const int i0 = 32 * mt + 8 * g4 + 4 * hh; const f32x4 eg = *(const LAS f32x4*)(vec + i0);
#pragma unroll
                                    for (int e = 0; e < 4; ++e) Oa[4 * g4 + e] *= eg[e]; }
#pragma unroll
                                for (int sq = 0; sq < 2; ++sq) {
                                    if (mt == 0) Oa = MFMA32(*(const LAS bf16x8*)(buf + O_QK + ((0 + sq) * 64 + lane) * 16), Uf[sq], Oa);
                                    else { Oa = MFMA32(*(const LAS bf16x8*)(buf + O_QK + ((2 + sq) * 64 + lane) * 16), Uf[sq], Oa);
                                           Oa = MFMA32(*(const LAS bf16x8*)(buf + O_QK + ((4 + sq) * 64 + lane) * 16), Uf[2 + sq], Oa); } }
#pragma unroll
                                for (int i = 0; i < 16; ++i) { const int ti = 32 * mt + (i & 3) + 8 * (i >> 2) + 4 * hh;
                                    ODN[((size_t)dir * MT + dn_row(b, dir, c, ti)) * D + h * 128 + 32 * n + r31] = (bf16)f2bf(Oa[i]); }
                                __builtin_amdgcn_sched_barrier(0);
                            }
                        }
                        asm volatile("" ::: "memory");
                        { const float cd = vec[192];
                          const int i16 = lane & 15, qq = i16 >> 2, pp = i16 & 3, gb = (lane >> 4) & 1;
                          const unsigned tra = (unsigned)(size_t)(buf + O_K) + (unsigned)((gb * 64 + (pp & 1) * 32 + 4 * hh + qq) * 16 + 8 * (pp >> 1));
#pragma unroll
                          for (int kt = 0; kt < 4; ++kt) {
#pragma unroll
                              for (int i = 0; i < 16; ++i) S[kt][i] *= cd;
                              v2u t0, t1, t2, t3, t4, t5, t6, t7;
#define TRO(ks, sec) ((((ks) >> 1) * 8 + 2 * kt) * 1024 + (16 * ((ks) & 1) + 8 * (sec)) * 16)
                              asm volatile("ds_read_b64_tr_b16 %0, %8 offset:%9\n\tds_read_b64_tr_b16 %1, %8 offset:%10\n\tds_read_b64_tr_b16 %2, %8 offset:%11\n\tds_read_b64_tr_b16 %3, %8 offset:%12\n\t"
                                           "ds_read_b64_tr_b16 %4, %8 offset:%13\n\tds_read_b64_tr_b16 %5, %8 offset:%14\n\tds_read_b64_tr_b16 %6, %8 offset:%15\n\tds_read_b64_tr_b16 %7, %8 offset:%16\n\ts_waitcnt lgkmcnt(0)"
                                           : "=&v"(t0), "=&v"(t1), "=&v"(t2), "=&v"(t3), "=&v"(t4), "=&v"(t5), "=&v"(t6), "=&v"(t7)
                                           : "v"(tra), "n"(TRO(0, 0)), "n"(TRO(0, 1)), "n"(TRO(1, 0)), "n"(TRO(1, 1)), "n"(TRO(2, 0)), "n"(TRO(2, 1)), "n"(TRO(3, 0)), "n"(TRO(3, 1)) : "memory");
#undef TRO
                              S[kt] = MFMA32(__builtin_bit_cast(bf16x8, (v4u){t0.x, t0.y, t1.x, t1.y}), Ue[0], S[kt]);
                              S[kt] = MFMA32(__builtin_bit_cast(bf16x8, (v4u){t2.x, t2.y, t3.x, t3.y}), Ue[1], S[kt]);
                              S[kt] = MFMA32(__builtin_bit_cast(bf16x8, (v4u){t4.x, t4.y, t5.x, t5.y}), Ue[2], S[kt]);
                              S[kt] = MFMA32(__builtin_bit_cast(bf16x8, (v4u){t6.x, t6.y, t7.x, t7.y}), Ue[3], S[kt]); } }
                        LDS_WAIT();
                        __builtin_amdgcn_s_barrier(); asm volatile("" ::: "memory");
                    }
                }
            }
            __syncthreads();
            {
                LAS unsigned char* Ks = lds;
                LAS unsigned char* Vt = lds + 49152;
                volatile LAS unsigned* qslot = (volatile LAS unsigned*)(lds + MISC_OFF + 256);
                const int nit = 512 + (ctx_out ? 32 : 0);
                const int r31 = lane & 31, hh = lane >> 5;
                for (int arep_ = 0; arep_ < NREP(14); ++arep_) for (;;) {
                    if (tid == 0) *qslot = __hip_atomic_fetch_add(ctl + CW_ATTQ + 64 * (l + 2 * arep_), 1u, __ATOMIC_RELAXED, __HIP_MEMORY_SCOPE_AGENT);
                    __syncthreads();
                    const int it = __builtin_amdgcn_readfirstlane((int)*qslot);
                    __syncthreads();
                    if (it >= nit) break;
                    const bool is_lat = it < 512;
                    const int b = is_lat ? it >> 6 : (it - 512) >> 2, nbk = is_lat ? (it >> 1) & 31 : ((it - 512) >> 1) & 1, kvh = it & 1;
                    const int q0 = nbk * 128, qrow0 = is_lat ? b * SEQ + q0 : NL + b * CTXL + q0, head = kvh * 8 + wave;
                    f32x16 O[4][2]; float mrow[4], lrow[4];
                    { const float sink = args.in[I_SINK][l * 16 + head];
#pragma unroll
                      for (int qt = 0; qt < 4; ++qt) { mrow[qt] = sink; lrow[qt] = 1.0f;
#pragma unroll
                          for (int dt = 0; dt < 2; ++dt)
#pragma unroll
                              for (int i = 0; i < 16; ++i) O[qt][dt][i] = 0.f; } }
                    const int nseg = is_lat ? 2 : 1;
                    for (int seg = 0; seg < nseg; ++seg) {
                        const int nk = seg == 0 ? 256 : 384, tbase = seg == 0 ? 0 : q0 - 128, tlim = seg == 0 ? CTXL : SEQ;
                        const int krow0 = seg == 0 ? NL + b * CTXL : b * SEQ;
                        const bf16* vsrc = seg == 0 ? VTC + ((size_t)(b * 2 + kvh) * 64) * CTXL : VTL + ((size_t)(b * 2 + kvh) * 64) * SEQ;
                        __syncthreads();
                        for (int p = tid; p < nk * 8; p += 512) { const int key = p >> 3, c = p & 7, tk = tbase + key;
                            v4u val = (v4u){0u, 0u, 0u, 0u};
                            if (tk >= 0 && tk < tlim) val = *(const v4u*)(P + (size_t)(krow0 + tk) * NP + C_ATK + kvh * 64 + 8 * c);
                            *(LAS v4u*)(Ks + key * 128 + 16 * (c ^ ((key >> 1) & 7))) = val; }
                        { const int ppd = nk >> 2;
                          for (int p = tid; p < 64 * ppd; p += 512) { const int dim = p / ppd, i = p - dim * ppd, tk = tbase + 4 * i;
                              v2u val = (v2u){0u, 0u};
                              if (tk >= 0 && tk < tlim) val = *(const v2u*)(vsrc + (size_t)dim * tlim + tk);
                              *(LAS v2u*)(Vt + dim * 776 + 8 * i) = val; } }
                        __syncthreads();
#pragma unroll
                        for (int qt = 0; qt < 4; ++qt) {
                            bf16x8 qf[4];
                            { const bf16* qg = P + (size_t)(qrow0 + 32 * qt + r31) * NP + C_ATQ + head * 64 + 8 * hh;
#pragma unroll
                              for (int sp = 0; sp < 4; ++sp) qf[sp] = *(const bf16x8*)(qg + 16 * sp); }
                            const int ntile = seg == 0 ? 8 : 9;
#pragma unroll 1
                            for (int w = 0; w < ntile; ++w) {
                                const int kb = seg == 0 ? 32 * w : 32 * (qt + w);
                                if (seg == 1) { const int tk0 = tbase + kb; if (tk0 < 0 || tk0 >= SEQ) continue; }
                                f32x16 sa;
#pragma unroll
                                for (int i = 0; i < 16; ++i) sa[i] = 0.f;
                                bf16x8 kf[4]; v2u vf[8];
                                { const int key = kb + r31; const int sw = (key >> 1) & 7; const unsigned kp = (unsigned)(size_t)Ks + (unsigned)(key * 128);
                                  const unsigned ka0 = kp + 16 * ((0 + hh) ^ sw), ka1 = kp + 16 * ((2 + hh) ^ sw), ka2 = kp + 16 * ((4 + hh) ^ sw), ka3 = kp + 16 * ((6 + hh) ^ sw);
                                  const unsigned va = (unsigned)(size_t)Vt + (unsigned)(r31 * 776 + 2 * (kb + 4 * hh));
                                  asm volatile("ds_read_b128 %0, %12\n\tds_read_b128 %1, %13\n\tds_read_b128 %2, %14\n\tds_read_b128 %3, %15\n\t"
                                               "ds_read_b64 %4, %16\n\tds_read_b64 %5, %16 offset:16\n\tds_read_b64 %6, %16 offset:32\n\tds_read_b64 %7, %16 offset:48\n\t"
                                               "ds_read_b64 %8, %16 offset:24832\n\tds_read_b64 %9, %16 offset:24848\n\tds_read_b64 %10, %16 offset:24864\n\tds_read_b64 %11, %16 offset:24880\n\ts_waitcnt lgkmcnt(0)"
                                               : "=&v"(kf[0]), "=&v"(kf[1]), "=&v"(kf[2]), "=&v"(kf[3]), "=&v"(vf[0]), "=&v"(vf[1]), "=&v"(vf[2]), "=&v"(vf[3]), "=&v"(vf[4]), "=&v"(vf[5]), "=&v"(vf[6]), "=&v"(vf[7])
                                               : "v"(ka0), "v"(ka1), "v"(ka2), "v"(ka3), "v"(va) : "memory");
#pragma unroll
                                  for (int sp = 0; sp < 4; ++sp) sa = __builtin_amdgcn_mfma_f32_32x32x16_bf16(kf[sp], qf[sp], sa, 0, 0, 0); }
                                if (seg == 1 && (w == 0 || w == 8)) {
#pragma unroll
                                    for (int i = 0; i < 16; ++i) { const int kr = (i & 3) + 8 * (i >> 2) + 4 * hh; const bool keep = (w == 0) ? (kr >= r31) : (kr <= r31); sa[i] = keep ? sa[i] : -INFINITY; } }
                                float mx = sa[0];
#pragma unroll
                                for (int i = 1; i < 16; ++i) mx = fmaxf(mx, sa[i]);
                                mx = fmaxf(mx, __shfl_xor(mx, 32));
                                const float mnew = fmaxf(mrow[qt], mx), alpha = fexp(mrow[qt] - mnew);
                                float rs = 0.f;
#pragma unroll
                                for (int i = 0; i < 16; ++i) { sa[i] = fexp(sa[i] - mnew); rs += sa[i]; }
                                rs += __shfl_xor(rs, 32);
                                lrow[qt] = lrow[qt] * alpha + rs; mrow[qt] = mnew;
                                if (__builtin_amdgcn_ballot_w64(alpha != 1.0f) != 0ull) {
#pragma unroll
                                    for (int dt = 0; dt < 2; ++dt)
#pragma unroll
                                        for (int i = 0; i < 16; ++i) O[qt][dt][i] *= alpha; }
                                bf16x8 pf[2];
#pragma unroll
                                for (int s2 = 0; s2 < 2; ++s2) { v4u pk;
                                    asm volatile("v_cvt_pk_bf16_f32 %0, %4, %5\n\tv_cvt_pk_bf16_f32 %1, %6, %7\n\tv_cvt_pk_bf16_f32 %2, %8, %9\n\tv_cvt_pk_bf16_f32 %3, %10, %11\n\ts_nop 1"
                                                 : "=&v"(pk[0]), "=&v"(pk[1]), "=&v"(pk[2]), "=&v"(pk[3])
                                                 : "v"(sa[8 * s2]), "v"(sa[8 * s2 + 1]), "v"(sa[8 * s2 + 2]), "v"(sa[8 * s2 + 3]), "v"(sa[8 * s2 + 4]), "v"(sa[8 * s2 + 5]), "v"(sa[8 * s2 + 6]), "v"(sa[8 * s2 + 7]));
                                    pf[s2] = __builtin_bit_cast(bf16x8, pk); }
#pragma unroll
                                for (int dt = 0; dt < 2; ++dt)
#pragma unroll
                                    for (int s2 = 0; s2 < 2; ++s2) { const v2u vlo = vf[4 * dt + 2 * s2], vhi = vf[4 * dt + 2 * s2 + 1];
                                        const v4u vv = (v4u){vlo.x, vlo.y, vhi.x, vhi.y};
                                        O[qt][dt] = __builtin_amdgcn_mfma_f32_32x32x16_bf16(__builtin_bit_cast(bf16x8, vv), pf[s2], O[qt][dt], 0, 0, 0); }
                            }
                        }
                    }
#pragma unroll
                    for (int qt = 0; qt < 4; ++qt) { const float inv = frcp(lrow[qt]);
                        bf16* yo = Y3 + (size_t)2 * MT * D + (size_t)(qrow0 + 32 * qt + r31) * D + head * 64 + 4 * hh;
#pragma unroll
                        for (int dt = 0; dt < 2; ++dt)
#pragma unroll
                            for (int g = 0; g < 4; ++g) { v2u o; o.x = pk2(O[qt][dt][4 * g + 0] * inv, O[qt][dt][4 * g + 1] * inv); o.y = pk2(O[qt][dt][4 * g + 2] * inv, O[qt][dt][4 * g + 3] * inv);
                                *(v2u*)(yo + 32 * dt + 8 * g) = o; } }
                }
            }
            __syncthreads();
            {
                constexpr int WPI = 272, VPI = 320;
                LAS unsigned char* Wl = lds; LAS unsigned char* Vl = lds + 128 * WPI;
                const int nchunks = ML / 128, nit = nchunks * 8;
                const int r31 = lane & 31, hh = lane >> 5, pt = wave >> 1, ct0 = 2 * (wave & 1);
                volatile LAS unsigned* qslot2 = (volatile LAS unsigned*)(lds + MISC_OFF + 320);
                for (;;) {
                    __syncthreads();
                    if (tid == 0) *qslot2 = __hip_atomic_fetch_add(ctl + CW_ATTQ + 64 * (4 + l), 1u, __ATOMIC_RELAXED, __HIP_MEMORY_SCOPE_AGENT);
                    __syncthreads();
                    const int it = __builtin_amdgcn_readfirstlane((int)*qslot2);
                    if (it >= nit) break;
                    const int ci = it >> 3, g = it & 7, r0 = ci * 128;
                    const float* wg = args.in[I_SGW] + ((size_t)l * 8 + g) * 128 * 128;
                    __syncthreads();
#pragma unroll
                    for (int k = 0; k < 8; ++k) { const int p = tid + 512 * k, prow = p >> 5, q4 = p & 31; const f32x4 w = *(const f32x4*)(wg + prow * 128 + 4 * q4);
                        *(LAS v2u*)(Wl + prow * WPI + 8 * q4) = (v2u){pk2(w.x, w.y), pk2(w.z, w.w)}; }
#pragma unroll
                    for (int k = 0; k < 4; ++k) { const int p = tid + 512 * k, q = p >> 4, c8 = p & 15;
                        *(LAS v4u*)(Vl + q * VPI + 16 * c8) = *(const v4u*)(P + (size_t)(r0 + q) * NP + C_SGV + g * 128 + 8 * c8); }
                    __syncthreads();
                    f32x16 acc[2];
#pragma unroll
                    for (int t = 0; t < 2; ++t)
#pragma unroll
                        for (int i = 0; i < 16; ++i) acc[t][i] = 0.f;
                    const int i16 = lane & 15, qq = i16 >> 2, pp = i16 & 3, gb = (lane >> 4) & 1;
                    const unsigned tra = (unsigned)(size_t)Vl + (unsigned)((8 * hh + qq) * VPI + 2 * (32 * ct0 + 16 * gb + 4 * pp));
#pragma unroll
                    for (int ks = 0; ks < 8; ++ks) {
                        const bf16x8 af = *(const LAS bf16x8*)(Wl + (32 * pt + r31) * WPI + 2 * (16 * ks + 8 * hh));
                        v2u t0, t1, t2, t3;
                        asm volatile("ds_read_b64_tr_b16 %0, %4 offset:%5\n\tds_read_b64_tr_b16 %1, %4 offset:%6\n\tds_read_b64_tr_b16 %2, %4 offset:%7\n\tds_read_b64_tr_b16 %3, %4 offset:%8\n\ts_waitcnt lgkmcnt(0)"
                                     : "=&v"(t0), "=&v"(t1), "=&v"(t2), "=&v"(t3)
                                     : "v"(tra), "n"(16 * ks * VPI), "n"((16 * ks + 4) * VPI), "n"(16 * ks * VPI + 64), "n"((16 * ks + 4) * VPI + 64) : "memory");
                        acc[0] = MFMA32(af, __builtin_bit_cast(bf16x8, (v4u){t0.x, t0.y, t1.x, t1.y}), acc[0]);
                        acc[1] = MFMA32(af, __builtin_bit_cast(bf16x8, (v4u){t2.x, t2.y, t3.x, t3.y}), acc[1]);
                    }
                    const float* sb = args.in[I_SGB] + ((size_t)l * 8 + g) * 128 + 32 * pt + 4 * hh;
                    f32x4 b4v[4]; unsigned uu[16];
#pragma unroll
                    for (int g4 = 0; g4 < 4; ++g4) { b4v[g4] = *(const f32x4*)(sb + 8 * g4);
#pragma unroll
                        for (int e = 0; e < 4; ++e) { const size_t row = (size_t)(r0 + 32 * pt + 8 * g4 + 4 * hh + e); const bf16* up = P + row * NP + C_SGU + g * 128 + 32 * ct0 + r31;
                            uu[4 * g4 + e] = (unsigned)up[0] | ((unsigned)up[32] << 16); } }
#pragma unroll
                    for (int g4 = 0; g4 < 4; ++g4)
#pragma unroll
                        for (int e = 0; e < 4; ++e) { const size_t row = (size_t)(r0 + 32 * pt + 8 * g4 + 4 * hh + e); bf16* yp = Y3 + row * D + g * 128 + 32 * ct0 + r31;
                            yp[0] = (bf16)f2bf(bflo(uu[4 * g4 + e]) * (acc[0][4 * g4 + e] + b4v[g4][e])); yp[32] = (bf16)f2bf(bfhi(uu[4 * g4 + e]) * (acc[1][4 * g4 + e] + b4v[g4][e])); }
                }
            }
        }
        SEAM(pb + 3);
        if (EN(6) && IN(pb + 4)) for (int rep_ = 0; rep_ < NREP(6); ++rep_) { HIDE_TID;
            for (int r = gw; r < ML; r += NGW) {
                float a[16], bq[16], g[16];
                ld16(ODN + (size_t)r * D + 16 * lane, a); ld16(ODN + ((size_t)MT + r) * D + 16 * lane, bq); ld16(P + (size_t)r * NP + C_DNG + 16 * lane, g);
                float ss = 0.f;
#pragma unroll
                for (int i = 0; i < 16; ++i) { a[i] += bq[i]; ss += a[i] * a[i]; }
                ss += __shfl_xor(ss, 1); ss += __shfl_xor(ss, 2); ss += __shfl_xor(ss, 4);
                const float rinv = rsqrtf(ss * (1.f / 128.f) + EPS);
                const float* ng = args.in[I_DNNG] + l * 128 + 16 * (lane & 7);
#pragma unroll
                for (int i = 0; i < 16; ++i) a[i] = a[i] * rinv * ng[i] * siluf_(g[i]);
                st16(Y3 + (size_t)MT * D + (size_t)r * D + 16 * lane, a);
            }
        }
        SEAM(pb + 4);
        if (EN(7) && IN(pb + 5)) for (int rep_ = 0; rep_ < NREP(7); ++rep_) { HIDE_TID;
            pg8::OrderMerge S; S.A = (const char*)Y3; S.Bt = (const char*)(WTPROJ + (size_t)l * 4 * 1024 * 1024); S.nM = ML / 256; S.nN = 4; S.G = G; S.c = bx;
            S.a_stride = (size_t)MT * D * 2; S.b_stride = (size_t)1024 * 1024 * 2;
            pg8::EpiMerge E{P + C_GATE, MB};
            pg8::gemm_phase<pg8::EpiMerge, pg8::OrderMerge>(lds, S, E, wave);
            { const int cv_rem = (ML / 256 * 4) % G, cv_short = cv_rem ? G - cv_rem : 0, cv_n1 = CV_N_TOT - (CV_E_QUOTA + CV_F_QUOTA) * 8 * cv_short;
              if (cv_rem && bx >= cv_rem) { LAS float* scr = (LAS float*)(lds + wave * 4096);
                  for (int k = 0; k < CV_E_QUOTA; ++k) expert_item(cv_n1 + ((bx - cv_rem) * 8 + wave) + k * (cv_short * 8), l, args.in[I_WGU], args.in[I_WDN], WTGU, WTDN, scr, lane); } }
        }
        SEAM(pb + 5);
        if (EN(8) && IN(pb + 6)) for (int rep_ = 0; rep_ < NREP(8); ++rep_) { HIDE_TID;
            pg8::OrderRect2 S; S.A = (const char*)MB; S.Bt = (const char*)(ws + WS_WOUT8) + (size_t)l * 1024 * 1024; S.G = G; S.c = bx; S.tile = (size_t)256 * 1024;
            S.nM0 = ML / 256; S.nN0 = 4; S.nM1 = 0; S.nN1 = 0;
            pg8::EpiStoreBf16 E{(bf16*)MF, 1024};
            pg8::gemm_phase<pg8::EpiStoreBf16, pg8::OrderRect2, false, true>(lds, S, E, wave);
            { const int cv_rem = (ML / 256 * 4) % G, cv_short = cv_rem ? G - cv_rem : 0, cv_n1 = CV_N_TOT - (CV_E_QUOTA + CV_F_QUOTA) * 8 * cv_short;
              if (cv_rem && bx >= cv_rem) { LAS float* scr = (LAS float*)(lds + wave * 4096);
                  for (int k = 0; k < CV_F_QUOTA; ++k) expert_item(cv_n1 + CV_E_QUOTA * 8 * cv_short + ((bx - cv_rem) * 8 + wave) + k * (cv_short * 8), l, args.in[I_WGU], args.in[I_WDN], WTGU, WTDN, scr, lane); } }
        }
        SEAM(pb + 6);
        const int RPB = (ML + G - 1) / G;
        if (EN(9) && IN(pb + 7)) for (int rep_ = 0; rep_ < NREP(9); ++rep_) { HIDE_TID;
            LAS float* rwT = (LAS float*)lds;
            LAS float* lg = (LAS float*)(lds + MISC_OFF + 1024) + wave * 32;
            LAS unsigned* hist = (LAS unsigned*)(lds + MISC_OFF + 512);
            const float* rw = args.in[I_RW] + (size_t)l * 1024 * 32;
            for (int i = tid; i < 32768; i += 512) { const int d = i >> 5, e = i & 31; rwT[e * 1024 + (d ^ ((e & 7) << 2))] = rw[i]; }
            if (tid < 32) hist[tid] = 0u;
            __syncthreads();
            const int rbeg = bx * RPB, rend = (rbeg + RPB) < ML ? (rbeg + RPB) : ML;
            f32x4 on[4], xn[4];
#define G_LOAD(rr) do { const int r_ = (rr) < rend ? (rr) : rend - 1; const float* xr_ = l == 0 ? (r_ < NL ? args.in[I_X] + (size_t)r_ * D : args.in[I_CTX] + (size_t)(r_ - NL) * D) : X + (size_t)r_ * D; const bf16* or_ = (const bf16*)MF + (size_t)r_ * D; \
                _Pragma("unroll") for (int j = 0; j < 4; ++j) { const v2u ow_ = ((const v2u*)or_)[64 * j + lane]; on[j] = (f32x4){bflo(ow_.x), bfhi(ow_.x), bflo(ow_.y), bfhi(ow_.y)}; xn[j] = ((const f32x4*)xr_)[64 * j + lane]; } } while (0)
            f32x4 npv[4], nfv[4];
#pragma unroll
            for (int j = 0; j < 4; ++j) { npv[j] = ((const f32x4*)(args.in[I_NPOST] + l * D))[64 * j + lane]; nfv[j] = ((const f32x4*)(args.in[I_NPREF] + l * D))[64 * j + lane]; }
            if (rbeg + wave < rend) G_LOAD(rbeg + wave);
            for (int r = rbeg + wave; r < rend; r += 8) {
                const float* md = MODL + (size_t)mod_slot(r) * 6144;
                f32x4 g1v[4], sh2v[4], sc2v[4];
#pragma unroll
                for (int j = 0; j < 4; ++j) { g1v[j] = ((const f32x4*)(md + 2048))[64 * j + lane]; sh2v[j] = ((const f32x4*)(md + 3072))[64 * j + lane]; sc2v[j] = ((const f32x4*)(md + 4096))[64 * j + lane]; }
                f32x4 o[4], x[4]; float s = 0.f;
#pragma unroll
                for (int j = 0; j < 4; ++j) { o[j] = on[j]; x[j] = xn[j]; s += (o[j].x * o[j].x + o[j].y * o[j].y) + (o[j].z * o[j].z + o[j].w * o[j].w); }
                asm volatile("" ::: "memory");
                G_LOAD(r + 8);
                asm volatile("" ::: "memory");
                const float rinv = rsqrtf(wave_sum(s) * (1.f / D) * (1.0f / 4096.0f) + EPS) * (1.0f / 64.0f); float s2 = 0.f;
#pragma unroll
                for (int j = 0; j < 4; ++j) { const f32x4 np = npv[j], g1 = g1v[j];
                    x[j] = x[j] + g1 * (o[j] * rinv * np); ((f32x4*)(X + (size_t)r * D))[64 * j + lane] = x[j];
                    s2 += (x[j].x * x[j].x + x[j].y * x[j].y) + (x[j].z * x[j].z + x[j].w * x[j].w); }
                const float rinv2 = rsqrtf(wave_sum(s2) * (1.f / D) + EPS);
                f32x4 h[4];
#pragma unroll
                for (int j = 0; j < 4; ++j) { const f32x4 nf = nfv[j], sh2 = sh2v[j], sc2 = sc2v[j];
                    h[j] = x[j] * rinv2 * nf * (sc2 + 1.0f) + sh2;
                    unsigned ob = __builtin_amdgcn_cvt_pk_fp8_f32(h[j].x, h[j].y, 0, false); ob = __builtin_amdgcn_cvt_pk_fp8_f32(h[j].z, h[j].w, ob, true);
                    ((unsigned*)((unsigned char*)H + (size_t)r * 1024))[64 * j + lane] = ob; }
                float lgt[32];
#pragma unroll
                for (int e = 0; e < 32; ++e) { float a0 = 0.f, a1 = 0.f;
#pragma unroll
                    for (int j = 0; j < 4; ++j) { const f32x4 w4 = *(const LAS f32x4*)(rwT + e * 1024 + ((4 * lane + 256 * j) ^ ((e & 7) << 2)));
                        a0 = fmaf(h[j].x, w4.x, a0); a1 = fmaf(h[j].y, w4.y, a1); a0 = fmaf(h[j].z, w4.z, a0); a1 = fmaf(h[j].w, w4.w, a1); }
                    lgt[e] = a0 + a1; }
                float r16[16], r8[8], r4[4], r2[2], r1;
                { const bool up = (lane & 32) != 0;
#pragma unroll
                  for (int i = 0; i < 16; ++i) { const float keep = up ? lgt[16 + i] : lgt[i], send = up ? lgt[i] : lgt[16 + i]; r16[i] = keep + __shfl_xor(send, 32); } }
                { const bool up = (lane & 16) != 0;
#pragma unroll
                  for (int i = 0; i < 8; ++i) { const float keep = up ? r16[8 + i] : r16[i], send = up ? r16[i] : r16[8 + i]; r8[i] = keep + __shfl_xor(send, 16); } }
                { const bool up = (lane & 8) != 0;
#pragma unroll
                  for (int i = 0; i < 4; ++i) { const float keep = up ? r8[4 + i] : r8[i], send = up ? r8[i] : r8[4 + i]; r4[i] = keep + __shfl_xor(send, 8); } }
                { const bool up = (lane & 4) != 0;
#pragma unroll
                  for (int i = 0; i < 2; ++i) { const float keep = up ? r4[2 + i] : r4[i], send = up ? r4[i] : r4[2 + i]; r2[i] = keep + __shfl_xor(send, 4); } }
                { const bool up = (lane & 2) != 0; const float keep = up ? r2[1] : r2[0], send = up ? r2[0] : r2[1]; r1 = keep + __shfl_xor(send, 2); }
                r1 += __shfl_xor(r1, 1);
                const int eo = lane >> 1;
                float val = r1 + args.in[I_RB][l * 32 + eo];
                float tv[4]; int ti[4];
#pragma unroll
                for (int k = 0; k < 4; ++k) { const float mxv = wave_max(val); const unsigned long long bal = __ballot(val == mxv);
                    const int bi = (__ffsll((long long)bal) - 1) >> 1; tv[k] = mxv; ti[k] = bi; if (eo == bi) val = -INFINITY; }
                if (lane < 4) {
                    const float e1 = fexp(tv[1] - tv[0]), e2 = fexp(tv[2] - tv[0]), e3 = fexp(tv[3] - tv[0]); const float inv = frcp(1.0f + e1 + e2 + e3);
                    const float gsel = lane == 0 ? inv : (lane == 1 ? e1 * inv : (lane == 2 ? e2 * inv : e3 * inv));
                    const int isel = lane == 0 ? ti[0] : (lane == 1 ? ti[1] : (lane == 2 ? ti[2] : ti[3]));
                    TOPI[(size_t)r * 4 + lane] = isel; GATE[(size_t)r * 4 + lane] = gsel;
                    atomicAdd((unsigned*)&hist[isel], 1u);
                }
            }
#undef G_LOAD
            __syncthreads();
            if (tid < 32) CNT[(size_t)bx * 32 + tid] = hist[tid];
        }
        SEAM(pb + 7);
        if (EN(10) && IN(pb + 8)) for (int rep_ = 0; rep_ < NREP(10); ++rep_) { HIDE_TID;
            LAS unsigned* red = (LAS unsigned*)lds;
            LAS unsigned* base = (LAS unsigned*)(lds + 8192);
            LAS unsigned* cur = (LAS unsigned*)(lds + 8192 + 256);
            LAS int* lpos = (LAS int*)(lds + 16384);
            { const int e = tid & 31, part = tid >> 5; unsigned tot = 0u, pre = 0u;
              for (int b2 = part; b2 < G; b2 += 16) { const unsigned c = CNT[(size_t)b2 * 32 + e]; tot += c; pre += (b2 < bx) ? c : 0u; }
              red[part * 64 + e] = tot; red[part * 64 + 32 + e] = pre; }
            __syncthreads();
            if (tid < 32) { unsigned tot = 0u, pre = 0u;
#pragma unroll
                for (int p = 0; p < 16; ++p) { tot += red[p * 64 + tid]; pre += red[p * 64 + 32 + tid]; }
                red[1024 + tid] = tot; red[1024 + 32 + tid] = pre; cur[tid] = 0u; }
            __syncthreads();
            if (tid == 0) { unsigned off = 0u;
                for (int e = 0; e < 32; ++e) { const unsigned tot = red[1024 + e], np = (tot + 255u) >> 8; base[e] = off + red[1024 + 32 + e]; red[1024 + 64 + e] = off;
                    if (bx == 0) for (unsigned p = 0; p < np; ++p) MOEI[64 + (off >> 8) + p] = (unsigned)e;
                    off += np << 8; }
                if (bx == 0) MOEI[0] = off >> 8; }
            __syncthreads();
            if (bx == 0) {
                for (int e = 0; e < 32; ++e) { const unsigned tot = red[1024 + e], beg = red[1024 + 64 + e] + tot, end = red[1024 + 64 + e] + (((tot + 255u) >> 8) << 8);
                    for (unsigned p = beg + tid; p < end; p += 512) ROWMAP[p] = 0; } }
            const int rbeg = bx * RPB, rend = (rbeg + RPB) < ML ? (rbeg + RPB) : ML;
            for (int idx = tid; idx < (rend - rbeg) * 4; idx += 512) { const int r = rbeg + (idx >> 2);
                const int e = TOPI[(size_t)r * 4 + (idx & 3)]; const int pos = (int)(base[e] + atomicAdd((unsigned*)&cur[e], 1u));
                SLOT[(size_t)r * 4 + (idx & 3)] = pos; ROWMAP[pos] = r; lpos[idx] = pos; }
            __syncthreads();
            { const unsigned char* H8 = (const unsigned char*)H; unsigned char* XG8 = ws + WS_XG;
              const int nr = rend - rbeg;
              for (int i0 = wave; i0 < nr; i0 += 32) {
                  v4u rowv[4];
#pragma unroll
                  for (int q = 0; q < 4; ++q) { const int i = (i0 + 8 * q) < nr ? (i0 + 8 * q) : (nr - 1); rowv[q] = ((const v4u*)(H8 + (size_t)(rbeg + i) * 1024))[lane]; }
                  asm volatile("" ::: "memory"); __builtin_amdgcn_sched_barrier(0);
#pragma unroll
                  for (int q = 0; q < 4; ++q) { const int i = i0 + 8 * q; if (i < nr) {
#pragma unroll
                      for (int k = 0; k < 4; ++k) ((v4u*)(XG8 + (size_t)lpos[4 * i + k] * 1024))[lane] = rowv[q]; } } } }
        }
        SEAM(pb + 8);
        if (EN(11) && IN(pb + 9)) for (int rep_ = 0; rep_ < NREP(11); ++rep_) { HIDE_TID;
            pg8::OrderMoe S; S.A = (const char*)(ws + WS_XG); S.Bt = (const char*)WTGU + (size_t)l * 32 * 2048 * 1024; S.nP = (int)__builtin_amdgcn_readfirstlane(MOEI[0]); S.nN = 8; S.G = G; S.c = bx;
            S.e_stride = (size_t)2048 * 1024; S.tile = (size_t)256 * 1024; S.p2e = MOEI + 64;
            pg8::EpiSwiglu E{ACT, args.in[I_BGU] + (size_t)l * 32 * 2048, 1.0f / 64.0f};
            pg8::gemm_phase<pg8::EpiSwiglu, pg8::OrderMoe, false, true>(lds, S, E, wave);
        }
        SEAM(pb + 9);
        if (EN(12) && IN(pb + 10)) for (int rep_ = 0; rep_ < NREP(12); ++rep_) { HIDE_TID;
            pg8::OrderMoe S; S.A = (const char*)ACT; S.Bt = (const char*)WTDN + (size_t)l * 32 * 1024 * 1024; S.nP = (int)__builtin_amdgcn_readfirstlane(MOEI[0]); S.nN = 4; S.G = G; S.c = bx;
            S.e_stride = (size_t)1024 * 1024; S.tile = (size_t)256 * 1024; S.p2e = MOEI + 64;
            pg8::EpiDown E{YS, args.in[I_BDN] + (size_t)l * 32 * 1024, 1.0f / 64.0f};
            pg8::gemm_phase<pg8::EpiDown, pg8::OrderMoe, false, true>(lds, S, E, wave);
        }
        SEAM(pb + 10);
        if (EN(13) && IN(pb + 11)) for (int rep_ = 0; rep_ < NREP(13); ++rep_) { HIDE_TID;
            int slB = 0; float gtB = 0.f; v2u ywA[4][4], ywB[4][4]; f32x4 xwA[4], xwB[4]; float gkA[4], gkB[4];
#define K_SLOT(rr, sl_, gt_) do { sl_ = 0; gt_ = 0.f; if ((rr) < ML && lane < 4) { sl_ = SLOT[(size_t)(rr) * 4 + lane]; gt_ = GATE[(size_t)(rr) * 4 + lane]; } } while (0)
#define K_ROWS(rr, sl_, gt_, yw_, xw_, gk_) do { const int r_ = (rr) < ML ? (rr) : ML - 1; _Pragma("unroll") for (int k = 0; k < 4; ++k) { const int sk = __shfl(sl_, k); gk_[k] = __shfl(gt_, k); \
                _Pragma("unroll") for (int j = 0; j < 4; ++j) yw_[k][j] = ((const v2u*)(YS + (size_t)sk * D))[64 * j + lane]; } \
                _Pragma("unroll") for (int j = 0; j < 4; ++j) xw_[j] = ((const f32x4*)(X + (size_t)r_ * D))[64 * j + lane]; } while (0)
            f32x4 nfK[4], ggK[4];
#pragma unroll
            for (int j = 0; j < 4; ++j) { nfK[j] = ((const f32x4*)(args.in[I_NPOSTF] + l * D))[64 * j + lane]; ggK[j] = ((const f32x4*)(args.in[I_NPRE] + D))[64 * j + lane]; }
            const int RWK = (ML + NGW - 1) / NGW, k0r = gw * RWK, k1r = (k0r + RWK) < ML ? (k0r + RWK) : ML;
            f32x4 g2K[4], shK[4], scK[4]; int curslotK = -1;
#pragma unroll
            for (int j = 0; j < 4; ++j) { g2K[j] = (f32x4){0.f, 0.f, 0.f, 0.f}; shK[j] = g2K[j]; scK[j] = g2K[j]; }
            { int sl0; float gt0; K_SLOT(k0r, sl0, gt0); K_ROWS(k0r, sl0, gt0, ywA, xwA, gkA); K_SLOT(k0r + 1, slB, gtB); }
            for (int r = k0r; r < k1r; ++r) {
                if (mod_slot(r) != curslotK) { curslotK = mod_slot(r); const float* md = MODL + (size_t)curslotK * 6144; const float* md1 = MOD + (size_t)(9 + curslotK) * 6144;
#pragma unroll
                    for (int j = 0; j < 4; ++j) { g2K[j] = ((const f32x4*)(md + 5120))[64 * j + lane]; if (l == 0) { shK[j] = ((const f32x4*)md1)[64 * j + lane]; scK[j] = ((const f32x4*)(md1 + 1024))[64 * j + lane]; } } }
                asm volatile("" ::: "memory");
                K_ROWS(r + 1, slB, gtB, ywB, xwB, gkB);
                K_SLOT(r + 2, slB, gtB);
                asm volatile("" ::: "memory");
                f32x4 y[4];
#pragma unroll
                for (int j = 0; j < 4; ++j) y[j] = (f32x4){0.f, 0.f, 0.f, 0.f};
#pragma unroll
                for (int k = 0; k < 4; ++k) { const float gk = gkA[k];
#pragma unroll
                    for (int j = 0; j < 4; ++j) { const v2u w = ywA[k][j];
                        y[j].x += gk * bflo(w.x); y[j].y += gk * bfhi(w.x); y[j].z += gk * bflo(w.y); y[j].w += gk * bfhi(w.y); } }
                float s = 0.f;
#pragma unroll
                for (int j = 0; j < 4; ++j) s += (y[j].x * y[j].x + y[j].y * y[j].y) + (y[j].z * y[j].z + y[j].w * y[j].w);
                const float rinv = rsqrtf(wave_sum(s) * (1.f / D) + EPS);
                f32x4 x[4];
#pragma unroll
                for (int j = 0; j < 4; ++j) { const f32x4 nf = nfK[j], g2 = g2K[j];
                    x[j] = xwA[j] + g2 * (y[j] * rinv * nf); }
                if (l == 0) {
#pragma unroll
                    for (int j = 0; j < 4; ++j) ((f32x4*)(X + (size_t)r * D))[64 * j + lane] = x[j];
                    float s2 = 0.f;
#pragma unroll
                    for (int j = 0; j < 4; ++j) s2 += (x[j].x * x[j].x + x[j].y * x[j].y) + (x[j].z * x[j].z + x[j].w * x[j].w);
                    const float rinv2 = rsqrtf(wave_sum(s2) * (1.f / D) + EPS);
#pragma unroll
                    for (int j = 0; j < 4; ++j) { const f32x4 gg = ggK[j], sh = shK[j], sc = scK[j];
                        const f32x4 hh = x[j] * rinv2 * gg * (sc + 1.0f) + sh;
                        v2u ob; ob.x = pk2(hh.x, hh.y); ob.y = pk2(hh.z, hh.w); ((v2u*)(H + (size_t)r * D))[64 * j + lane] = ob; }
                } else {
#pragma unroll
                    for (int j = 0; j < 4; ++j) ((f32x4*)(args.out + (size_t)r * D))[64 * j + lane] = x[j];
                }
#pragma unroll
                for (int k = 0; k < 4; ++k) { gkA[k] = gkB[k];
#pragma unroll
                    for (int j = 0; j < 4; ++j) ywA[k][j] = ywB[k][j]; }
#pragma unroll
                for (int j = 0; j < 4; ++j) xwA[j] = xwB[j];
            }
#undef K_SLOT
#undef K_ROWS
        }
        SEAM(pb + 11);
    }
}

__global__ void __launch_bounds__(512, 2) mk_fwd(Args args) {
    extern __shared__ __attribute__((aligned(16))) unsigned char lds_raw[];
    LAS unsigned char* lds = (LAS unsigned char*)lds_raw;
    const int tid0 = threadIdx.x;
    KCtx K;
    K.lds = lds; K.ws = args.ws; K.out = args.out;
#pragma unroll
    for (int i = 0; i < 30; ++i) K.in[i] = args.in[i];
    K.tid0 = tid0; K.wave = __builtin_amdgcn_readfirstlane(tid0 >> 6); K.G = gridDim.x; K.bx = blockIdx.x; K.gw = K.bx * 8 + K.wave; K.NGW = K.G * 8; K.lo = args.ph_lo; K.hi = args.ph_hi;
    volatile LAS unsigned* MISC = (volatile LAS unsigned*)(lds + MISC_OFF);
    { const int wave = K.wave; HIDE_TID; for (int u = tid; u < (LDS_BYTES - MISC_OFF) / 4; u += 512) ((LAS unsigned*)(lds + MISC_OFF))[u] = 0u; }
    __syncthreads();
    unsigned* ctl = (unsigned*)(args.ws + WS_CTL);
    const XcdBarrier bar = xcd_barrier_post(ctl + CW_BAR, MISC + 8);
    prologue_body(K, bar);
    layer_body<0>(K, bar);
    layer_body<1>(K, bar);
}

constexpr int N_PHASES = 26;
extern "C" void kernel_launch(void* const* d_in, const int* in_sizes, int n_in, void* d_out, int out_size, void* d_ws, size_t ws_size, hipStream_t stream) {
    static int grid = 0;
    if (grid == 0) {
        if (n_in != 30 || ws_size < WS_END) { fprintf(stderr, "kernel_launch: need 30 inputs and %zu bytes of workspace (got %d, %zu)\n", (size_t)WS_END, n_in, ws_size); grid = -1; return; }
        int dev = 0, cus = 0, per_cu = 0;
        if (hipGetDevice(&dev) != hipSuccess || hipDeviceGetAttribute(&cus, hipDeviceAttributeMultiprocessorCount, dev) != hipSuccess) { grid = -1; return; }
        if (hipFuncSetAttribute((const void*)mk_fwd, hipFuncAttributeMaxDynamicSharedMemorySize, LDS_BYTES) != hipSuccess) { fprintf(stderr, "kernel_launch: hipFuncSetAttribute failed\n"); grid = -1; return; }
        if (hipOccupancyMaxActiveBlocksPerMultiprocessor(&per_cu, (const void*)mk_fwd, 512, LDS_BYTES) != hipSuccess || per_cu < 1)
            fprintf(stderr, "kernel_launch: occupancy query reports %d workgroups per CU\n", per_cu);
        (void)hipGetLastError();
        grid = cus;
    }
    if (grid < 0) return;
    if (hipMemsetAsync((char*)d_ws + WS_CTL, 0, CTL_ZERO_BYTES, stream) != hipSuccess) return;
    Args a{};
    for (int i = 0; i < 30; ++i) a.in[i] = (const float*)d_in[i];
    a.out = (float*)d_out; a.ws = (unsigned char*)d_ws; a.ph_lo = 0; a.ph_hi = N_PHASES;
    hipLaunchKernelGGL(mk_fwd, dim3(grid), dim3(512), LDS_BYTES, stream, a);
}
```

```cpp
#include <hip/hip_runtime.h>
#include <cstdio>
#include <cstdint>

#define GAS __attribute__((address_space(1)))
#define LAS __attribute__((address_space(3)))
typedef unsigned short bf16;
typedef unsigned v4u __attribute__((ext_vector_type(4)));
typedef unsigned v2u __attribute__((ext_vector_type(2)));
typedef float f32x4 __attribute__((ext_vector_type(4)));
typedef float f32x2 __attribute__((ext_vector_type(2)));
typedef short bf16x8 __attribute__((ext_vector_type(8)));
typedef float f32x16 __attribute__((ext_vector_type(16)));

constexpr int D = 1024, NB = 8, SEQ = 4096, CTXL = 256;
constexpr int NL = NB * SEQ, NC = NB * CTXL, MT = NL + NC;
constexpr int DIN = 10528, NP = 10752;
constexpr int C_DNK = 0, C_DNV = 1024, C_ATK = 2048, C_ATV = 2176, C_DNA = 2304, C_DNB = 2320, C_DNQ = 2560, C_DNG = 3584, C_ATQ = 4608, C_SGU = 5632, C_SGV = 6656, C_GATE = 7680;
constexpr int NEXP = 32, TOPK = 4, DE = 1024;
constexpr float EPS = 1e-6f;
constexpr int MAXPAN = 640;

constexpr size_t MiB = 1u << 20;
constexpr size_t WS_CTL = 0, CTL_ZERO_BYTES = 1 * MiB;
constexpr size_t WS_MOD = 1 * MiB;
constexpr size_t WS_WTIN = 2 * MiB;
constexpr size_t WS_WTPROJ = 44 * MiB;
constexpr size_t WS_WTGU = 60 * MiB;
constexpr size_t WS_H8 = WS_WTGU + 128 * MiB;
constexpr size_t WS_WTIN8 = WS_WTGU + 224 * MiB;
constexpr size_t WS_WOUT8 = WS_WTGU + 192 * MiB;
constexpr size_t WS_WPROJ8 = WS_WTGU + 200 * MiB;
constexpr size_t WS_WTDN = 316 * MiB;
constexpr size_t WS_H = 444 * MiB;
constexpr size_t WS_X = 512 * MiB;
constexpr size_t WS_Y3 = 648 * MiB;
constexpr size_t WS_MF = 852 * MiB;
constexpr size_t WS_MB = 988 * MiB;
constexpr size_t WS_P = 1056 * MiB;
constexpr size_t WS_XG = WS_P, WS_ACT = WS_P + 288 * MiB, WS_YS = WS_P;
constexpr size_t WS_QN = 1770 * MiB, WS_KN = 1838 * MiB, WS_VN = 1906 * MiB;
constexpr size_t WS_LDEC = 1974 * MiB, WS_BETA = 1977 * MiB;
constexpr size_t WS_TOPI = 1980 * MiB, WS_GATE = 1981 * MiB, WS_SLOT = 1982 * MiB;
constexpr size_t WS_MOE = 1983 * MiB;
constexpr size_t WS_CNT = 1984 * MiB;
constexpr size_t WS_ROWMAP = 1985 * MiB;
constexpr size_t WS_VTL = 1990 * MiB, WS_VTC = 1998 * MiB;
constexpr size_t WS_TREC = WS_H, WS_QKREC = WS_MB;
constexpr size_t WS_VEC = 1999 * MiB;
constexpr size_t WS_END = 2048 * MiB;
constexpr int CW_BAR = 4096, CW_ATTQ = 8192;

constexpr int RING_BYTES = 131072;
constexpr int MISC_OFF = RING_BYTES;
constexpr int LDS_BYTES = 147456;

__device__ __forceinline__ float bflo(unsigned u) { return __uint_as_float(u << 16); }
__device__ __forceinline__ float bfhi(unsigned u) { return __uint_as_float(u & 0xffff0000u); }
__device__ __forceinline__ float bf1(bf16 b) { return __uint_as_float(((unsigned)b) << 16); }
__device__ __forceinline__ unsigned pk2(float lo, float hi) { unsigned r; asm volatile("v_cvt_pk_bf16_f32 %0, %1, %2" : "=v"(r) : "v"(lo), "v"(hi)); return r; }
__device__ __forceinline__ unsigned f2bf(float f) { return pk2(f, f) & 0xffffu; }
__device__ __forceinline__ unsigned f2fp8(float f) { unsigned r; asm volatile("v_cvt_pk_fp8_f32 %0, %1, %1" : "=v"(r) : "v"(f)); return r & 0xffu; }
__device__ __forceinline__ float wave_sum(float v) {
#pragma unroll
    for (int o = 1; o < 64; o <<= 1) v += __shfl_xor(v, o);
    return v;
}
__device__ __forceinline__ float wave_max(float v) {
#pragma unroll
    for (int o = 1; o < 64; o <<= 1) v = fmaxf(v, __shfl_xor(v, o));
    return v;
}
__device__ __forceinline__ void ld16(const bf16* p, float (&f)[16]) {
    const v4u a = *(const v4u*)p, b = *(const v4u*)(p + 8);
    f[0] = bflo(a.x); f[1] = bfhi(a.x); f[2] = bflo(a.y); f[3] = bfhi(a.y); f[4] = bflo(a.z); f[5] = bfhi(a.z); f[6] = bflo(a.w); f[7] = bfhi(a.w);
    f[8] = bflo(b.x); f[9] = bfhi(b.x); f[10] = bflo(b.y); f[11] = bfhi(b.y); f[12] = bflo(b.z); f[13] = bfhi(b.z); f[14] = bflo(b.w); f[15] = bfhi(b.w);
}
__device__ __forceinline__ void st16(bf16* p, const float (&f)[16]) {
    v4u a, b;
    a.x = pk2(f[0], f[1]); a.y = pk2(f[2], f[3]); a.z = pk2(f[4], f[5]); a.w = pk2(f[6], f[7]);
    b.x = pk2(f[8], f[9]); b.y = pk2(f[10], f[11]); b.z = pk2(f[12], f[13]); b.w = pk2(f[14], f[15]);
    *(v4u*)p = a; *(v4u*)(p + 8) = b;
}
__device__ __forceinline__ float fexp(float x) { return __builtin_amdgcn_exp2f(x * 1.4426950408889634f); }
__device__ __forceinline__ float frcp(float x) { return __builtin_amdgcn_rcpf(x); }
__device__ __forceinline__ float sigmoidf_(float x) { return frcp(1.0f + fexp(-x)); }
__device__ __forceinline__ float siluf_(float x) { return x * frcp(1.0f + fexp(-x)); }
__device__ __forceinline__ float gelu_tanh(float x) { const float u2 = 1.5957691216057308f * (x + 0.044715f * x * x * x); return x * frcp(1.0f + fexp(-u2)); }
__device__ __forceinline__ float softplusf_(float x) { return fmaxf(x, 0.0f) + log1pf(fexp(-fabsf(x))); }
__device__ __forceinline__ int lane_fresh() { int r; asm volatile("v_mbcnt_lo_u32_b32 %0, -1, 0\n\tv_mbcnt_hi_u32_b32 %0, -1, %0" : "=v"(r)); return r; }
__device__ __forceinline__ int hide(int x) { asm volatile("" : "+v"(x)); return x; }
#define LDS_WAIT() asm volatile("s_waitcnt lgkmcnt(0)" ::: "memory")
#define VM_WAIT() asm volatile("s_waitcnt vmcnt(0)" ::: "memory")

#define XB_TMO      128
#define XB_XCNT(j)  (256  + 64 * (j))
#define XB_XSUB(j)  (1280 + 64 * (j))
#define XB_XGEN(j)  (2304 + 64 * (j))
#define XB_TOP      3328
#define XB_TOPGEN   3392
#define XCD_BAR_WORDS 3456
#define XB_SPIN_CAP (1u << 22)

__device__ __forceinline__ unsigned xb_ld(unsigned* p)              { return __hip_atomic_load(p, __ATOMIC_RELAXED, __HIP_MEMORY_SCOPE_AGENT); }
__device__ __forceinline__ unsigned xb_add(unsigned* p, unsigned v) { return __hip_atomic_fetch_add(p, v, __ATOMIC_RELAXED, __HIP_MEMORY_SCOPE_AGENT); }
__device__ __forceinline__ unsigned xb_xcc_id() { return (unsigned)__builtin_amdgcn_s_getreg((3 << 11) | 20) & 0xFu; }
#define XB_SPIN(cond, bar) do { unsigned _sp = 0; while (cond) { __builtin_amdgcn_s_sleep(1); \
    if ((++_sp & 255u) == 0u) { if (xb_ld(&(bar)[XB_TMO])) break; if (_sp > XB_SPIN_CAP) { atomicAdd(&(bar)[XB_TMO], 1u); break; } } } } while (0)

struct XcdBarrier { unsigned* bar; unsigned x; volatile LAS unsigned* st; };

__device__ __forceinline__ XcdBarrier xcd_barrier_post(unsigned* bar, volatile LAS unsigned* st) {
    XcdBarrier b; b.bar = bar; b.x = xb_xcc_id(); b.st = st;
    if (threadIdx.x == 0) (void)xb_add(&bar[XB_XCNT(b.x)], 1u);
    return b;
}
__device__ __forceinline__ void xcd_barrier_complete(unsigned* bar, unsigned x, unsigned& nloc, unsigned& nx) {
    const unsigned G = gridDim.x * gridDim.y * gridDim.z;
    unsigned sum, cnt, mine, sp = 0u;
    for (;;) {
        sum = 0u; cnt = 0u; mine = 0u;
#pragma unroll
        for (unsigned j = 0; j < 16; ++j) { const unsigned c = xb_ld(&bar[XB_XCNT(j)]); sum += c; cnt += (c > 0u) ? 1u : 0u; mine = (j == x) ? c : mine; }
        if (sum == G) break;
        __builtin_amdgcn_s_sleep(1);
        if ((++sp & 255u) == 0u) { if (xb_ld(&bar[XB_TMO])) break; if (sp > XB_SPIN_CAP) { atomicAdd(&bar[XB_TMO], 1u); break; } }
    }
    nloc = mine > 0u ? mine : 1u; nx = cnt > 0u ? cnt : 1u;
}
__device__ __forceinline__ void xcd_barrier(const XcdBarrier& b) {
    asm volatile("s_waitcnt vmcnt(0)" ::: "memory");
    __syncthreads();
    if (threadIdx.x == 0) {
        unsigned* bar = b.bar;
        __builtin_amdgcn_s_waitcnt(0);
        unsigned nloc = b.st[0], nx = b.st[1];
        if (nloc == 0u) { xcd_barrier_complete(bar, b.x, nloc, nx); b.st[0] = nloc; b.st[1] = nx; }
        const unsigned old = xb_add(&bar[XB_XSUB(b.x)], 1u);
        const unsigned gen = old / nloc;
        if (old + 1u == (gen + 1u) * nloc) {
            __builtin_amdgcn_fence(__ATOMIC_RELEASE, "agent");
            asm volatile("s_waitcnt vmcnt(0)" ::: "memory");
            const unsigned og = xb_add(&bar[XB_TOP], 1u);
            const unsigned tg = og / nx;
            if (og + 1u == (tg + 1u) * nx) xb_add(&bar[XB_TOPGEN], 1u);
            else XB_SPIN(xb_ld(&bar[XB_TOPGEN]) == tg, bar);
            __builtin_amdgcn_fence(__ATOMIC_ACQUIRE, "agent");
            xb_add(&bar[XB_XGEN(b.x)], 1u);
            asm volatile("s_waitcnt vmcnt(0)" ::: "memory");
        } else {
            XB_SPIN(xb_ld(&bar[XB_XGEN(b.x)]) == gen, bar);
            __builtin_amdgcn_fence(__ATOMIC_ACQUIRE, "agent");
            asm volatile("s_waitcnt vmcnt(0)" ::: "memory");
        }
    }
    __syncthreads();
}

typedef int v8i __attribute__((ext_vector_type(8)));
typedef int v4i __attribute__((ext_vector_type(4)));
namespace pg8 {
constexpr int BM = 256, BK = 64, HALF = 128, HTB = HALF * BK * 2, STAGE_BYTES = 8 * HTB, NXCD = 8, WGM = 8;
__host__ __device__ __forceinline__ int lds_byte(int r, int c) { const int st = (r >> 4) * 2 + (c >> 5), rr = r & 15, cc = c & 31, ob = rr * 64 + cc * 2; return st * 1024 + (ob ^ (((ob >> 9) & 1) << 5)); }
__host__ __device__ __forceinline__ void stage_rc(int b, int& R, int& C) { const int st = b / 1024, sb = b % 1024, swz = sb ^ (((sb >> 9) & 1) << 5); R = (st >> 1) * 16 + swz / 64; C = (st & 1) * 32 + (swz % 64) / 2; }
__host__ __device__ __forceinline__ int perm32(int rho) { const int n = rho >> 4, i = rho & 15; return 8 * (i >> 2) + 4 * n + (i & 3); }

struct Unit { int pm, pn, z; };

__device__ __forceinline__ void rect_map(int L, int nM, int nN, int& pm, int& pn) {
    const int nwg = nM * nN;
    int wgid = L; { const int q = nwg / NXCD, r = nwg % NXCD, xcd = wgid % NXCD, off = wgid / NXCD; wgid = (xcd < r ? xcd * (q + 1) : r * (q + 1) + (xcd - r) * q) + off; }
    const int nig = WGM * nN, gid = wgid / nig, fm = gid * WGM, gsz = (nM - fm) < WGM ? (nM - fm) : WGM;
    pm = fm + ((wgid % nig) % gsz); pn = (wgid % nig) / gsz;
}
struct OrderRect2 {
    const char* A; const char* Bt; int nM0, nN0, nM1, nN1, G, c, pn0; size_t tile;
    __device__ __forceinline__ bool next(int i, Unit& u) const {
        long L = (long)i * G + c; const int n0 = nM0 * nN0, n1 = nM1 * nN1;
        if (L < n0) { rect_map((int)L, nM0, nN0, u.pm, u.pn); u.pn += pn0; u.z = 0; return true; }
        L -= n0;
        if (L < n1) { rect_map((int)L, nM1, nN1, u.pm, u.pn); u.pm += nM0; u.z = 0; return true; }
        return false;
    }
    __device__ __forceinline__ const char* aptr(const Unit& u) const { return A + (size_t)u.pm * tile; }
    __device__ __forceinline__ const char* bptr(const Unit& u) const { return Bt + (size_t)u.pn * tile; }
};
struct OrderMerge {
    const char* A; const char* Bt; int nM, nN, G, c; size_t a_stride, b_stride, tile;
    __device__ __forceinline__ bool next(int i, Unit& u) const {
        const int round = i / 3, br = i - 3 * round; const long L = (long)round * G + c;
        if (L >= (long)nM * nN) return false;
        rect_map((int)L, nM, nN, u.pm, u.pn); u.z = br; return true;
    }
    __device__ __forceinline__ const char* aptr(const Unit& u) const { return A + (size_t)u.z * a_stride + (size_t)u.pm * tile; }
    __device__ __forceinline__ const char* bptr(const Unit& u) const { return Bt + (size_t)u.z * b_stride + (size_t)u.pn * tile; }
};
struct OrderMoe {
    const char* A; const char* Bt; int nP, nN, G, c; size_t e_stride, tile; const unsigned* p2e;
    __device__ __forceinline__ bool next(int i, Unit& u) const {
        const long L = (long)i * G + c; if (L >= (long)nP * nN) return false;
        rect_map((int)L, nP, nN, u.pm, u.pn); u.pm = __builtin_amdgcn_readfirstlane(u.pm); u.pn = __builtin_amdgcn_readfirstlane(u.pn); u.z = (int)p2e[u.pm]; return true;
    }
    __device__ __forceinline__ const char* aptr(const Unit& u) const { return A + (size_t)u.pm * tile; }
    __device__ __forceinline__ const char* bptr(const Unit& u) const { return Bt + (size_t)u.z * e_stride + (size_t)u.pn * tile; }
};

struct OrderMoeG {
    const char* A; const char* Bt; int nP, nN, G, c; size_t e_stride, b_tile; const unsigned* p2e; const int* rowmap;
    __device__ __forceinline__ bool next(int i, Unit& u) const {
        const long L = (long)i * G + c; if (L >= (long)nP * nN) return false;
        rect_map((int)L, nP, nN, u.pm, u.pn); u.pm = __builtin_amdgcn_readfirstlane(u.pm); u.pn = __builtin_amdgcn_readfirstlane(u.pn); u.z = (int)p2e[u.pm]; return true;
    }
    __device__ __forceinline__ const char* aptr(const Unit&) const { return A; }
    __device__ __forceinline__ const char* bptr(const Unit& u) const { return Bt + (size_t)u.z * e_stride + (size_t)u.pn * b_tile; }
};
__device__ __forceinline__ unsigned cvt_pk_bf16(float lo, float hi) { unsigned r; asm volatile("v_cvt_pk_bf16_f32 %0, %1, %2" : "=v"(r) : "v"(lo), "v"(hi)); return r; }

struct EpiStoreBf16 {
    static constexpr bool PERM = true, MUT = false;
    bf16* O; int ldc; float ascale;
    __device__ __forceinline__ void operator()(const f32x4 (&acc)[2][2][4][2], const Unit& u, int wr, int wc, int fr, int fq) const {
        const int row0 = u.pm * BM + wr * 64 + fr, col0 = u.pn * BM + wc * 32 + 8 * fq;
#pragma unroll
        for (int ai = 0; ai < 2; ++ai)
#pragma unroll
            for (int m = 0; m < 4; ++m) { bf16* rowp = O + (size_t)(row0 + ai * HALF + m * 16) * ldc + col0;
#pragma unroll
                for (int bj = 0; bj < 2; ++bj) { const f32x4 v0 = acc[ai][bj][m][0] * ascale, v1 = acc[ai][bj][m][1] * ascale;
                    v4u w; w.x = cvt_pk_bf16(v0[0], v0[1]); w.y = cvt_pk_bf16(v0[2], v0[3]); w.z = cvt_pk_bf16(v1[0], v1[1]); w.w = cvt_pk_bf16(v1[2], v1[3]);
                    __builtin_nontemporal_store(w, (v4u*)(rowp + bj * HALF)); } }
    }
};
struct EpiF32 {
    static constexpr bool PERM = false, MUT = false;
    float* C;
    __device__ __forceinline__ void operator()(const f32x4 (&acc)[2][2][4][2], const Unit& u, int wr, int wc, int fr, int fq) const {
        const int row0 = u.pm * BM + wr * 64 + fr, col0 = u.pn * BM + wc * 32 + 4 * fq;
#pragma unroll
        for (int ai = 0; ai < 2; ++ai)
#pragma unroll
            for (int m = 0; m < 4; ++m) { float* rowp = C + (size_t)(row0 + ai * HALF + m * 16) * 1024 + col0;
#pragma unroll
                for (int bj = 0; bj < 2; ++bj)
#pragma unroll
                    for (int n = 0; n < 2; ++n) *(f32x4*)(rowp + bj * HALF + n * 16) = acc[ai][bj][m][n]; }
    }
};
struct EpiMerge {
    static constexpr bool PERM = true, MUT = true;
    const bf16* Pg; bf16* MB;
    __device__ __forceinline__ void mut(f32x4 (&acc)[2][2][4][2], const Unit& u, int wr, int wc, int fr, int fq) const {
        const int row0 = u.pm * BM + wr * 64 + fr, col0 = u.pn * BM + wc * 32 + 8 * fq; const int br = u.z;
        v4u gv[16];
#pragma unroll
        for (int ai = 0; ai < 2; ++ai)
#pragma unroll
            for (int m = 0; m < 4; ++m)
#pragma unroll
                for (int bj = 0; bj < 2; ++bj) gv[(ai * 4 + m) * 2 + bj] = *(const v4u*)(Pg + (size_t)(row0 + ai * HALF + m * 16) * NP + br * 1024 + col0 + bj * HALF);
#pragma unroll
        for (int ai = 0; ai < 2; ++ai) {
#pragma unroll
            for (int m = 0; m < 4; ++m) { const size_t r = (size_t)(row0 + ai * HALF + m * 16);
#pragma unroll
                for (int bj = 0; bj < 2; ++bj) { const int c = col0 + bj * HALF; const v4u ga = gv[(ai * 4 + m) * 2 + bj];
                    f32x4 v0 = acc[ai][bj][m][0], v1 = acc[ai][bj][m][1];
                    v0[0] *= bflo(ga.x); v0[1] *= bfhi(ga.x); v0[2] *= bflo(ga.y); v0[3] *= bfhi(ga.y); v1[0] *= bflo(ga.z); v1[1] *= bfhi(ga.z); v1[2] *= bflo(ga.w); v1[3] *= bfhi(ga.w);
                    acc[ai][bj][m][0] = v0; acc[ai][bj][m][1] = v1;
                    if (br == 2) { v0 *= (1.0f / 64.0f); v1 *= (1.0f / 64.0f);
                        v2u w; w.x = __builtin_amdgcn_cvt_pk_fp8_f32(v0[0], v0[1], 0, false); w.x = __builtin_amdgcn_cvt_pk_fp8_f32(v0[2], v0[3], w.x, true);
                        w.y = __builtin_amdgcn_cvt_pk_fp8_f32(v1[0], v1[1], 0, false); w.y = __builtin_amdgcn_cvt_pk_fp8_f32(v1[2], v1[3], w.y, true);
                        *(v2u*)((unsigned char*)MB + r * 1024 + c) = w; } } } }
    }
};
struct EpiSwiglu {
    static constexpr bool PERM = true, MUT = false;
    bf16* ACT; const float* bgu; float ascale;
    __device__ __forceinline__ void operator()(const f32x4 (&acc)[2][2][4][2], const Unit& u, int wr, int wc, int fr, int fq) const {
        const int row0 = u.pm * BM + wr * 64 + fr, colg = u.pn * HALF + wc * 32 + 8 * fq;
        const float* bp = bgu + (size_t)u.z * 2048 + colg;
        const f32x4 bg0 = *(const f32x4*)bp, bg1 = *(const f32x4*)(bp + 4), bl0 = *(const f32x4*)(bp + 1024), bl1 = *(const f32x4*)(bp + 1028);
#pragma unroll
        for (int ai = 0; ai < 2; ++ai)
#pragma unroll
            for (int m = 0; m < 4; ++m) {
                f32x4 g0 = acc[ai][0][m][0] * ascale + bg0, g1 = acc[ai][0][m][1] * ascale + bg1, l0 = acc[ai][1][m][0] * ascale + bl0, l1 = acc[ai][1][m][1] * ascale + bl1;
                f32x4 o0, o1;
#pragma unroll
                for (int j = 0; j < 4; ++j) {
                    const float ga = __builtin_amdgcn_fmed3f(g0[j], -3.0e38f, 7.0f), la = __builtin_amdgcn_fmed3f(l0[j], -7.0f, 7.0f); o0[j] = ga * frcp(1.0f + __builtin_amdgcn_exp2f(ga * -2.4554669595f)) * (la + 1.0f);
                    const float gb = __builtin_amdgcn_fmed3f(g1[j], -3.0e38f, 7.0f), lb = __builtin_amdgcn_fmed3f(l1[j], -7.0f, 7.0f); o1[j] = gb * frcp(1.0f + __builtin_amdgcn_exp2f(gb * -2.4554669595f)) * (lb + 1.0f); }
                v2u w; w.x = __builtin_amdgcn_cvt_pk_fp8_f32(o0[0], o0[1], 0, false); w.x = __builtin_amdgcn_cvt_pk_fp8_f32(o0[2], o0[3], w.x, true);
                w.y = __builtin_amdgcn_cvt_pk_fp8_f32(o1[0], o1[1], 0, false); w.y = __builtin_amdgcn_cvt_pk_fp8_f32(o1[2], o1[3], w.y, true);
                *(v2u*)((unsigned char*)ACT + (size_t)(row0 + ai * HALF + m * 16) * 1024 + colg) = w; }
    }
};
struct EpiDown {
    static constexpr bool PERM = true, MUT = false;
    bf16* YS; const float* bd; float ascale;
    __device__ __forceinline__ void operator()(const f32x4 (&acc)[2][2][4][2], const Unit& u, int wr, int wc, int fr, int fq) const {
        const int row0 = u.pm * BM + wr * 64 + fr, col0 = u.pn * BM + wc * 32 + 8 * fq;
        const float* bp = bd + (size_t)u.z * 1024 + col0;
        f32x4 bv[2][2];
#pragma unroll
        for (int bj = 0; bj < 2; ++bj)
#pragma unroll
            for (int n = 0; n < 2; ++n) bv[bj][n] = *(const f32x4*)(bp + bj * HALF + 4 * n);
#pragma unroll
        for (int ai = 0; ai < 2; ++ai)
#pragma unroll
            for (int m = 0; m < 4; ++m) { bf16* rowp = YS + (size_t)(row0 + ai * HALF + m * 16) * 1024 + col0;
#pragma unroll
                for (int bj = 0; bj < 2; ++bj) { const f32x4 v0 = acc[ai][bj][m][0] * ascale + bv[bj][0], v1 = acc[ai][bj][m][1] * ascale + bv[bj][1];
                    v4u w; w.x = cvt_pk_bf16(v0[0], v0[1]); w.y = cvt_pk_bf16(v0[2], v0[3]); w.z = cvt_pk_bf16(v1[0], v1[1]); w.w = cvt_pk_bf16(v1[2], v1[3]);
                    *(v4u*)(rowp + bj * HALF) = w; } }
    }
};

template <class Epi, class Sched, bool GATHER = false, bool FP8 = false>
__device__ __forceinline__ void gemm_phase(LAS unsigned char* lds, const Sched& S, const Epi& E, const int wave_id) {
    const int wid = wave_id, lane = lane_fresh(), tid = wid * 64 + lane, wr = wid >> 2, wc = wid & 3, fr = lane & 15, fq = lane >> 4;
    constexpr int K = 1024, KB = FP8 ? 1024 : 2048, nt = KB / (BK * 2);
    unsigned voffA[2], voffB[2]; int gR[2], gC[2];
#pragma unroll
    for (int i = 0; i < 2; ++i) { int R, C; stage_rc(tid * 16 + i * 8192, R, C); const int Rb = Epi::PERM ? ((R & ~31) + perm32(R & 31)) : R; gR[i] = R; gC[i] = C;
        voffA[i] = (unsigned)(R * KB + C * 2); voffB[i] = (unsigned)(Rb * KB + C * 2); }
    unsigned vaC[2][2], vaN[2][2];
    int rmN[2][2];
#define PG8_RLOAD(dst, un) do { _Pragma("unroll") for (int hf = 0; hf < 2; ++hf) _Pragma("unroll") for (int i = 0; i < 2; ++i) dst[hf][i] = S.rowmap[(un).pm * 256 + hf * 128 + gR[i]]; } while (0)
#define PG8_RCONV(dst, src) do { _Pragma("unroll") for (int hf = 0; hf < 2; ++hf) _Pragma("unroll") for (int i = 0; i < 2; ++i) dst[hf][i] = (unsigned)(src[hf][i] * KB + gC[i] * 2); } while (0)
    const size_t kstep = (size_t)(BK * 2);
    const size_t hstep = (size_t)HALF * KB;
    const unsigned ldsw = (unsigned)wid * 1024u;
    const int aoff = lds_byte(wr * 64 + fr, fq * 8), boff = lds_byte(wc * 32 + fr, fq * 8);
#define PG8_SA(b, h) (((b) * 2 + (h)) * HTB)
#define PG8_SB(b, h) ((4 + (b) * 2 + (h)) * HTB)
#define PG8_STAGE(bufoff, gbase, voff) do { _Pragma("unroll") for (int _i = 0; _i < 2; ++_i) \
        __builtin_amdgcn_global_load_lds((const unsigned*)((const char*)(gbase) + (voff)[_i]), (LAS unsigned*)(lds + (bufoff) + ldsw + _i * 8192), 16, 0, 0); } while (0)
#define PG8_LDA(dst, b, h) do { if constexpr (FP8) { _Pragma("unroll") for (int m = 0; m < 4; ++m) { const v4i lo_ = *(const LAS v4i*)(lds + PG8_SA(b, h) + aoff + m * 2048), hi_ = *(const LAS v4i*)(lds + PG8_SA(b, h) + aoff + m * 2048 + 1024); dst##8[m] = __builtin_shufflevector(lo_, hi_, 0, 1, 2, 3, 4, 5, 6, 7); } } \
        else { _Pragma("unroll") for (int m = 0; m < 4; ++m) _Pragma("unroll") for (int k = 0; k < 2; ++k) dst[m][k] = *(const LAS bf16x8*)(lds + PG8_SA(b, h) + aoff + m * 2048 + k * 1024); } } while (0)
#define PG8_LDB(dst, b, h) do { if constexpr (FP8) { _Pragma("unroll") for (int n = 0; n < 2; ++n) { const v4i lo_ = *(const LAS v4i*)(lds + PG8_SB(b, h) + boff + n * 2048), hi_ = *(const LAS v4i*)(lds + PG8_SB(b, h) + boff + n * 2048 + 1024); dst##8[n] = __builtin_shufflevector(lo_, hi_, 0, 1, 2, 3, 4, 5, 6, 7); } } \
        else { _Pragma("unroll") for (int n = 0; n < 2; ++n) _Pragma("unroll") for (int k = 0; k < 2; ++k) dst[n][k] = *(const LAS bf16x8*)(lds + PG8_SB(b, h) + boff + n * 2048 + k * 1024); } } while (0)
#define PG8_MMA(ai, bj, At, Bt) do { __builtin_amdgcn_s_setprio(1); if constexpr (FP8) { _Pragma("unroll") for (int m = 0; m < 4; ++m) _Pragma("unroll") for (int n = 0; n < 2; ++n) \
            asm volatile("v_mfma_f32_16x16x128_f8f6f4 %0, %1, %2, %0" : "+v"(acc[ai][bj][m][n]) : "v"(Bt##8[n]), "v"(At##8[m])); } \
        else { _Pragma("unroll") for (int m = 0; m < 4; ++m) _Pragma("unroll") for (int n = 0; n < 2; ++n) _Pragma("unroll") for (int k = 0; k < 2; ++k) \
        acc[ai][bj][m][n] = __builtin_amdgcn_mfma_f32_16x16x32_bf16(Bt[n][k], At[m][k], acc[ai][bj][m][n], 0, 0, 0); } __builtin_amdgcn_s_setprio(0); } while (0)
#define PG8_WAIT_V(n) asm volatile("s_waitcnt vmcnt(" #n ")" ::: "memory")
#define PG8_WAIT_L(n) asm volatile("s_waitcnt lgkmcnt(" #n ")" ::: "memory")
#define PG8_BAR __builtin_amdgcn_s_barrier()
#define PG8_SCHED __builtin_amdgcn_sched_barrier(0)
    Unit cur, nxt; int ui = 0;
    if (!S.next(0, cur)) return;
    f32x4 acc[2][2][4][2];
#pragma unroll
    for (int a = 0; a < 2; ++a)
#pragma unroll
        for (int b = 0; b < 2; ++b)
#pragma unroll
            for (int m = 0; m < 4; ++m)
#pragma unroll
                for (int n = 0; n < 2; ++n) acc[a][b][m][n] = (f32x4){0.f, 0.f, 0.f, 0.f};
    bf16x8 At[4][2], B0[2][2], B1[2][2];
    v8i At8[4], B08[2], B18[2];
    const char* cA = S.aptr(cur); const char* cB = S.bptr(cur);
    if constexpr (GATHER) { int rm0[2][2]; PG8_RLOAD(rm0, cur); PG8_RCONV(vaC, rm0); Unit n1; if (S.next(1, n1)) PG8_RLOAD(rmN, n1); }
#define PG8_STAGE_A(bufoff, gbase, hf, useN) do { if constexpr (GATHER) { if (useN) PG8_STAGE(bufoff, gbase, vaN[hf]); else PG8_STAGE(bufoff, gbase, vaC[hf]); } else PG8_STAGE(bufoff, (gbase) + (hf) * hstep, voffA); } while (0)
    PG8_STAGE(PG8_SB(0, 0), cB, voffB); PG8_STAGE_A(PG8_SA(0, 0), cA, 0, false); PG8_STAGE(PG8_SB(0, 1), cB + hstep, voffB); PG8_STAGE_A(PG8_SA(0, 1), cA, 1, false);
    if (wr == 1) PG8_BAR;
    PG8_WAIT_V(4); PG8_BAR;
    PG8_STAGE(PG8_SB(1, 0), cB + kstep, voffB); PG8_STAGE_A(PG8_SA(1, 0), cA + kstep, 0, false); PG8_STAGE(PG8_SB(1, 1), cB + hstep + kstep, voffB);
    PG8_WAIT_V(6); PG8_BAR;
    for (;;) {
        const bool has_next = S.next(ui + 1, nxt);
        const char* nA = has_next ? S.aptr(nxt) : cA; const char* nB = has_next ? S.bptr(nxt) : cB;
        if constexpr (GATHER) { if (has_next) PG8_RCONV(vaN, rmN); else {
#pragma unroll
            for (int hf = 0; hf < 2; ++hf)
#pragma unroll
                for (int i = 0; i < 2; ++i) vaN[hf][i] = vaC[hf][i]; }
            Unit nn; if (S.next(ui + 2, nn)) PG8_RLOAD(rmN, nn); }
#pragma unroll 1
        for (int t = 0; t < nt; t += 2) {
            const bool last = (t == nt - 2);
            const char* a1 = cA + (size_t)(t + 1) * kstep;
            const char* a2 = last ? nA : cA + (size_t)(t + 2) * kstep; const char* b2 = last ? nB : cB + (size_t)(t + 2) * kstep;
            const char* a3 = a2 + kstep; const char* b3 = b2 + kstep;
            PG8_LDB(B0, 0, 0); PG8_SCHED; PG8_LDA(At, 0, 0); PG8_STAGE_A(PG8_SA(1, 1), a1, 1, false);
            PG8_WAIT_L(8); PG8_BAR; PG8_WAIT_L(0); PG8_MMA(0, 0, At, B0); PG8_BAR; PG8_SCHED;
            PG8_LDB(B1, 0, 1); PG8_STAGE(PG8_SB(0, 0), b2, voffB);
            PG8_BAR; PG8_WAIT_L(0); PG8_MMA(0, 1, At, B1); PG8_BAR;
            PG8_LDA(At, 0, 1); PG8_STAGE_A(PG8_SA(0, 0), a2, 0, last);
            PG8_BAR; PG8_WAIT_L(0); PG8_MMA(1, 0, At, B0); PG8_BAR; PG8_SCHED;
            PG8_STAGE(PG8_SB(0, 1), b2 + hstep, voffB);
            PG8_WAIT_V(6); PG8_BAR; PG8_MMA(1, 1, At, B1); PG8_BAR;
            PG8_LDB(B0, 1, 0); PG8_SCHED; PG8_LDA(At, 1, 0); PG8_STAGE_A(PG8_SA(0, 1), a2, 1, last);
            PG8_WAIT_L(8); PG8_BAR; PG8_WAIT_L(0); PG8_MMA(0, 0, At, B0); PG8_BAR; PG8_SCHED;
            PG8_LDB(B1, 1, 1); PG8_STAGE(PG8_SB(1, 0), b3, voffB);
            PG8_BAR; PG8_WAIT_L(0); PG8_MMA(0, 1, At, B1); PG8_BAR;
            PG8_LDA(At, 1, 1); PG8_STAGE_A(PG8_SA(1, 0), a3, 0, last);
            PG8_BAR; PG8_WAIT_L(0); PG8_MMA(1, 0, At, B0); PG8_BAR; PG8_SCHED;
            PG8_STAGE(PG8_SB(1, 1), b3 + hstep, voffB);
            PG8_WAIT_V(6); PG8_BAR; PG8_MMA(1, 1, At, B1); PG8_BAR;
        }
        if constexpr (FP8) asm volatile("s_nop 15\n\ts_nop 15" ::: "memory");
        bool keep = false;
        if constexpr (Epi::MUT) { E.mut(acc, cur, wr, wc, fr, fq); keep = cur.z != 2; } else { const int le_ = lane_fresh(); E(acc, cur, wr, wc, le_ & 15, le_ >> 4); }
        if (!has_next) break;
        if (!keep)
#pragma unroll
        for (int a = 0; a < 2; ++a)
#pragma unroll
            for (int b = 0; b < 2; ++b)
#pragma unroll
                for (int m = 0; m < 4; ++m)
#pragma unroll
                    for (int n = 0; n < 2; ++n) acc[a][b][m][n] = (f32x4){0.f, 0.f, 0.f, 0.f};
        cur = nxt; cA = nA; cB = nB; ++ui;
        if constexpr (GATHER) {
#pragma unroll
            for (int hf = 0; hf < 2; ++hf)
#pragma unroll
                for (int i = 0; i < 2; ++i) vaC[hf][i] = vaN[hf][i]; }
    }
    PG8_WAIT_V(0);
    if (wr == 0) PG8_BAR;
    PG8_BAR;
#undef PG8_SA
#undef PG8_SB
#undef PG8_STAGE
#undef PG8_STAGE_A
#undef PG8_RLOAD
#undef PG8_RCONV
#undef PG8_LDA
#undef PG8_LDB
#undef PG8_MMA
#undef PG8_WAIT_V
#undef PG8_WAIT_L
#undef PG8_BAR
#undef PG8_SCHED
}
}


constexpr int DN_NCH = 68, DN_ITEMS = 8 * 8 * 2 * DN_NCH;
__device__ __forceinline__ int dn_row(int b, int dir, int c, int i) {
    const bool cx = c < 4; const int len = cx ? CTXL : SEQ, base = cx ? NL + b * CTXL : b * SEQ, p = (cx ? c : c - 4) * 64 + i;
    return base + (dir ? len - 1 - p : p);
}
__device__ __forceinline__ bf16x8 pack_frag(const f32x16& x, const int s) {
    v4u p;
    if (s == 0) asm volatile("s_nop 15\n\tv_cvt_pk_bf16_f32 %0, %4, %5\n\tv_cvt_pk_bf16_f32 %1, %6, %7\n\tv_cvt_pk_bf16_f32 %2, %8, %9\n\tv_cvt_pk_bf16_f32 %3, %10, %11\n\ts_nop 1"
               : "=&v"(p[0]), "=&v"(p[1]), "=&v"(p[2]), "=&v"(p[3]) : "v"(x[0]), "v"(x[1]), "v"(x[2]), "v"(x[3]), "v"(x[4]), "v"(x[5]), "v"(x[6]), "v"(x[7]));
    else asm volatile("s_nop 15\n\tv_cvt_pk_bf16_f32 %0, %4, %5\n\tv_cvt_pk_bf16_f32 %1, %6, %7\n\tv_cvt_pk_bf16_f32 %2, %8, %9\n\tv_cvt_pk_bf16_f32 %3, %10, %11\n\ts_nop 1"
               : "=&v"(p[0]), "=&v"(p[1]), "=&v"(p[2]), "=&v"(p[3]) : "v"(x[8]), "v"(x[9]), "v"(x[10]), "v"(x[11]), "v"(x[12]), "v"(x[13]), "v"(x[14]), "v"(x[15]));
    return __builtin_bit_cast(bf16x8, p);
}
#define MFMA32(a, b, c) __builtin_amdgcn_mfma_f32_32x32x16_bf16((a), (b), (c), 0, 0, 0)
#define LDFRAG8(dst, addr, OFF) asm volatile("ds_read_b128 %0, %8 offset:%9\n\tds_read_b128 %1, %8 offset:%10\n\tds_read_b128 %2, %8 offset:%11\n\tds_read_b128 %3, %8 offset:%12\n\t" \
        "ds_read_b128 %4, %8 offset:%13\n\tds_read_b128 %5, %8 offset:%14\n\tds_read_b128 %6, %8 offset:%15\n\tds_read_b128 %7, %8 offset:%16\n\ts_waitcnt lgkmcnt(0)" \
        : "=&v"(dst[0]), "=&v"(dst[1]), "=&v"(dst[2]), "=&v"(dst[3]), "=&v"(dst[4]), "=&v"(dst[5]), "=&v"(dst[6]), "=&v"(dst[7]) \
        : "v"(addr), "n"((OFF)), "n"((OFF) + 1024), "n"((OFF) + 2048), "n"((OFF) + 3072), "n"((OFF) + 4096), "n"((OFF) + 5120), "n"((OFF) + 6144), "n"((OFF) + 7168) : "memory")
#define LDFRAG6(dst, addr, OFF) asm volatile("ds_read_b128 %0, %6 offset:%7\n\tds_read_b128 %1, %6 offset:%8\n\tds_read_b128 %2, %6 offset:%9\n\tds_read_b128 %3, %6 offset:%10\n\t" \
        "ds_read_b128 %4, %6 offset:%11\n\tds_read_b128 %5, %6 offset:%12\n\ts_waitcnt lgkmcnt(0)" \
        : "=&v"(dst[0]), "=&v"(dst[1]), "=&v"(dst[2]), "=&v"(dst[3]), "=&v"(dst[4]), "=&v"(dst[5]) \
        : "v"(addr), "n"((OFF)), "n"((OFF) + 1024), "n"((OFF) + 2048), "n"((OFF) + 3072), "n"((OFF) + 4096), "n"((OFF) + 5120) : "memory")

struct Args { const float* in[30]; float* out; unsigned char* ws; int ph_lo, ph_hi; };
enum { I_X = 0, I_C, I_CTX, I_CCTX, I_WMOD, I_BMOD, I_NPRE, I_NPOST, I_NPREF, I_NPOSTF, I_WIN, I_SGLNG, I_SGLNB, I_SGW, I_SGB, I_CONVW, I_ALOG, I_DTB, I_DNNG, I_SINK,
       I_WPSG, I_WPDN, I_WPAT, I_WOUT, I_RW, I_RB, I_WGU, I_BGU, I_WDN, I_BDN };

struct Fr {
    LAS unsigned char* lds; int tid, lane, wave, G, bx, gw, NGW;
    const float* in[30]; float* out; unsigned char* ws;
};

__device__ __forceinline__ int row_batch(int r) { return r < NL ? r / SEQ : (r - NL) / CTXL; }
__device__ __forceinline__ int mod_slot(int r) { return r < NL ? r / SEQ : 8; }

__device__ __forceinline__ void transpose_item(const float* W, int N, int k0, int n0, bf16* WT, int drow0, LAS float* scr, int lane) {
#pragma unroll 8
    for (int i = 0; i < 32; ++i) { const int kk = 2 * i + (lane >> 5); scr[kk * 33 + (lane & 31)] = W[(size_t)(k0 + kk) * N + n0 + (lane & 31)]; }
    LDS_WAIT();
    const int c = lane & 7;
#pragma unroll
    for (int j = 0; j < 4; ++j) { const int n = (lane >> 3) + 8 * j; const LAS float* s = scr + (8 * c) * 33 + n;
        v4u o; o.x = pk2(s[0 * 33], s[1 * 33]); o.y = pk2(s[2 * 33], s[3 * 33]); o.z = pk2(s[4 * 33], s[5 * 33]); o.w = pk2(s[6 * 33], s[7 * 33]);
        *(v4u*)(WT + (size_t)(drow0 + n) * 1024 + k0 + 8 * c) = o; }
    LDS_WAIT();
}

__device__ __forceinline__ void transpose_item_small(const float* W, int N, int k0, int n0, bf16* WT, int drow0, LAS float* scr, int lane) {
    const int kr = lane >> 3, c4 = lane & 7;
    f32x4 v[8];
#pragma unroll
    for (int i = 0; i < 8; ++i) v[i] = *(const f32x4*)(W + (size_t)(k0 + 8 * i + kr) * N + n0 + 4 * c4);
    const int n = lane & 31, kh = lane >> 5;
#pragma unroll
    for (int sub = 0; sub < 4; ++sub) {
#pragma unroll
        for (int hf = 0; hf < 2; ++hf) { LAS float* d = scr + (8 * hf + kr) * 33 + 4 * c4; const f32x4 w = v[2 * sub + hf]; d[0] = w.x; d[1] = w.y; d[2] = w.z; d[3] = w.w; }
        LDS_WAIT();
        const LAS float* sp = scr + (8 * kh) * 33 + n;
        v4u o; o.x = pk2(sp[0 * 33], sp[1 * 33]); o.y = pk2(sp[2 * 33], sp[3 * 33]); o.z = pk2(sp[4 * 33], sp[5 * 33]); o.w = pk2(sp[6 * 33], sp[7 * 33]);
        *(v4u*)(WT + (size_t)(drow0 + n) * 1024 + k0 + 16 * sub + 8 * kh) = o;
        LDS_WAIT();
    }
}

__device__ __forceinline__ void transpose_item_small8(const float* W, int N, int k0, int n0, unsigned char* WT8, int drow0, LAS float* scr, int lane) {
    const int kr = lane >> 3, c4 = lane & 7;
    f32x4 v[8];
#pragma unroll
    for (int i = 0; i < 8; ++i) v[i] = *(const f32x4*)(W + (size_t)(k0 + 8 * i + kr) * N + n0 + 4 * c4);
    const int n = lane & 31, kh = lane >> 5;
#pragma unroll
    for (int sub = 0; sub < 4; ++sub) {
#pragma unroll
        for (int hf = 0; hf < 2; ++hf) { LAS float* d = scr + (8 * hf + kr) * 33 + 4 * c4; const f32x4 w = v[2 * sub + hf] * 64.0f; d[0] = w.x; d[1] = w.y; d[2] = w.z; d[3] = w.w; }
        LDS_WAIT();
        const LAS float* sp = scr + (8 * kh) * 33 + n;
        v2u o; o.x = __builtin_amdgcn_cvt_pk_fp8_f32(sp[0 * 33], sp[1 * 33], 0, false); o.x = __builtin_amdgcn_cvt_pk_fp8_f32(sp[2 * 33], sp[3 * 33], o.x, true);
        o.y = __builtin_amdgcn_cvt_pk_fp8_f32(sp[4 * 33], sp[5 * 33], 0, false); o.y = __builtin_amdgcn_cvt_pk_fp8_f32(sp[6 * 33], sp[7 * 33], o.y, true);
        *(v2u*)(WT8 + (size_t)(drow0 + n) * 1024 + k0 + 16 * sub + 8 * kh) = o;
        LDS_WAIT();
    }
}
constexpr int CV_IT_GU = 16 * 64, CV_IT_DN = 16 * 32, CV_N_GU = 32 * CV_IT_GU, CV_N_DN = 32 * CV_IT_DN, CV_N_TOT = CV_N_GU + CV_N_DN;
constexpr int CV_E_QUOTA = 12, CV_F_QUOTA = 4;
__device__ __forceinline__ void expert_item(int it, int l, const float* wgu, const float* wdn, bf16* WTGU, bf16* WTDN, LAS float* scr, int lane) {
    int r = it;
    if (r < CV_N_GU) { const int e = r / CV_IT_GU; r -= e * CV_IT_GU; const int nb = r >> 4, kb = r & 15; const int n0 = 32 * nb; const size_t le = (size_t)l * 32 + e;
        const int drow = n0 < 1024 ? 256 * (n0 >> 7) + (n0 & 127) : 256 * ((n0 - 1024) >> 7) + 128 + ((n0 - 1024) & 127);
        transpose_item_small8(wgu + le * 1024 * 2048, 2048, 64 * kb, n0, (unsigned char*)WTGU + le * 2048 * 1024, drow, scr, lane); }
    else { r -= CV_N_GU; const int e = r / CV_IT_DN; r -= e * CV_IT_DN; const int nb = r >> 4, kb = r & 15; const size_t le = (size_t)l * 32 + e;
        transpose_item_small8(wdn + le * 1024 * 1024, 1024, 64 * kb, 32 * nb, (unsigned char*)WTDN + le * 1024 * 1024, 32 * nb, scr, lane); }
}
__device__ __forceinline__ void cv_proc(const f32x4 (&v)[8], bf16* dst, LAS float* scr, int lane) {
    const int kr = lane >> 3, c4 = lane & 7, n = lane & 31, kh = lane >> 5;
#pragma unroll
    for (int sub = 0; sub < 4; ++sub) {
#pragma unroll
        for (int hf = 0; hf < 2; ++hf) { LAS float* d = scr + (8 * hf + kr) * 33 + 4 * c4; const f32x4 w = v[2 * sub + hf]; d[0] = w.x; d[1] = w.y; d[2] = w.z; d[3] = w.w; }
        LDS_WAIT();
        const LAS float* sp = scr + (8 * kh) * 33 + n;
        v4u o; o.x = pk2(sp[0 * 33], sp[1 * 33]); o.y = pk2(sp[2 * 33], sp[3 * 33]); o.z = pk2(sp[4 * 33], sp[5 * 33]); o.w = pk2(sp[6 * 33], sp[7 * 33]);
        *(v4u*)(dst + 16 * sub) = o;
        LDS_WAIT();
    }
}

__device__ __forceinline__ void mod_rms_row(const float* xrow, const float* g, const float* sh, const float* sc, bf16* orow, int lane) {
    f32x4 v[4]; float s = 0.f;
#pragma unroll
    for (int j = 0; j < 4; ++j) { v[j] = ((const f32x4*)xrow)[64 * j + lane]; s += (v[j].x * v[j].x + v[j].y * v[j].y) + (v[j].z * v[j].z + v[j].w * v[j].w); }
    const float rinv = rsqrtf(wave_sum(s) * (1.f / D) + EPS);
#pragma unroll
    for (int j = 0; j < 4; ++j) { const f32x4 gg = ((const f32x4*)g)[64 * j + lane], a = ((const f32x4*)sc)[64 * j + lane], b = ((const f32x4*)sh)[64 * j + lane];
        const f32x4 h = v[j] * rinv * gg * (a + 1.0f) + b;
        v2u o; o.x = pk2(h.x, h.y); o.y = pk2(h.z, h.w); ((v2u*)orow)[64 * j + lane] = o; }
}

#ifndef PHMASK
#define PHMASK 0xffffffffu
#endif
#define IN(k) (lo <= (k) && (k) < hi)
#define EN(j) ((PHMASK >> (j)) & 1u)
#ifndef DUPMASK
#define DUPMASK 0u
#endif
#define NREP(j) (1 + (int)(((DUPMASK >> (j)) & 1u) && l == 0))
#define BOTH(k) (IN(k) && IN((k) + 1))
#define SEAM(k) do { if (BOTH(k)) xcd_barrier(bar); } while (0)
#define HIDE_TID const int lane = lane_fresh(), tid = wave * 64 + lane; (void)lane; (void)tid
struct KCtx {
    LAS unsigned char* lds; unsigned char* ws; const float* in[30]; float* out;
    int tid0, wave, G, bx, gw, NGW, lo, hi;
};
#define KCTX_LOCALS \
    LAS unsigned char* lds = K.lds; unsigned char* ws = K.ws; \
    const int tid0 = K.tid0, wave = K.wave, G = K.G, bx = K.bx, gw = K.gw, NGW = K.NGW, lo = K.lo, hi = K.hi; \
    struct { const float* const* in; float* out; } args{K.in, K.out}; \
    float* MOD = (float*)(ws + WS_MOD); \
    bf16* WTIN = (bf16*)(ws + WS_WTIN); bf16* WTPROJ = (bf16*)(ws + WS_WTPROJ); bf16* WTGU = (bf16*)(ws + WS_WTGU); bf16* WTDN = (bf16*)(ws + WS_WTDN); \
    bf16* H = (bf16*)(ws + WS_H); float* X = (float*)(ws + WS_X); bf16* Y3 = (bf16*)(ws + WS_Y3); float* MF = (float*)(ws + WS_MF); bf16* ODN = (bf16*)(ws + WS_MF); \
    bf16* MB = (bf16*)(ws + WS_MB); bf16* P = (bf16*)(ws + WS_P); bf16* XG = (bf16*)(ws + WS_XG); bf16* ACT = (bf16*)(ws + WS_ACT); bf16* YS = (bf16*)(ws + WS_YS); \
    bf16* QN = (bf16*)(ws + WS_QN); bf16* KN = (bf16*)(ws + WS_KN); bf16* VN = (bf16*)(ws + WS_VN); \
    float* LDEC = (float*)(ws + WS_LDEC); float* BETA = (float*)(ws + WS_BETA); \
    int* TOPI = (int*)(ws + WS_TOPI); float* GATE = (float*)(ws + WS_GATE); int* SLOT = (int*)(ws + WS_SLOT); \
    unsigned* MOEI = (unsigned*)(ws + WS_MOE); unsigned* CNT = (unsigned*)(ws + WS_CNT); unsigned* ctl = (unsigned*)(ws + WS_CTL); int* ROWMAP = (int*)(ws + WS_ROWMAP); (void)ROWMAP; \
    bf16* VTL = (bf16*)(ws + WS_VTL); bf16* VTC = (bf16*)(ws + WS_VTC); (void)ctl; (void)VTL; (void)VTC; \
    unsigned char* TREC = ws + WS_TREC; unsigned char* QKREC = ws + WS_QKREC; float* VEC = (float*)(ws + WS_VEC); (void)TREC; (void)QKREC; (void)VEC; \
    (void)MOD; (void)WTIN; (void)WTPROJ; (void)WTGU; (void)WTDN; (void)H; (void)X; (void)Y3; (void)MF; (void)ODN; (void)MB; (void)P; (void)XG; (void)ACT; (void)YS; (void)QN; (void)KN; (void)VN; \
    (void)LDEC; (void)BETA; (void)TOPI; (void)GATE; (void)SLOT; (void)MOEI; (void)CNT; (void)gw; (void)NGW; (void)wave; (void)G; (void)bx; (void)lds; (void)args
__device__ __forceinline__ void prologue_body(const KCtx& K, const XcdBarrier& bar) {
    KCTX_LOCALS;
    if (EN(0) && IN(0)) { HIDE_TID;
        LAS float* scr = (LAS float*)(lds + wave * 16384);
        constexpr int IT_WIN = 16 * 73, IT_PAD = 7, IT_PROJ = 16 * 32, IT_GU = 16 * 64, IT_DN = 16 * 32;
        constexpr int N_WIN = 2 * IT_WIN, N_PAD = 2 * IT_PAD, N_PROJ = 0 * IT_PROJ, N_GU = 64 * IT_GU, N_DN = 64 * IT_DN;
        (void)N_GU; (void)N_DN;
        for (int it = gw; it < N_PAD; it += NGW) { const int l = it / IT_PAD, pb = it % IT_PAD; bf16* dst = WTIN + (size_t)l * NP * 1024 + (size_t)(2336 + 32 * pb) * 1024;
            for (int i = lane; i < 32 * 1024 / 8; i += 64) ((v4u*)dst)[i] = (v4u){0u, 0u, 0u, 0u}; }
        {
            constexpr int N_CV = N_WIN + N_PROJ;
            f32x4 va[8], vb[8], vc[8]; const float* sp_; int Nn_; bf16 *da, *db, *dc;
#define P0_DECODE(it_, d) do { int r = (it_) < N_CV ? (it_) : N_CV - 1; const int kr = lane >> 3, c4 = lane & 7, n = lane & 31, kh = lane >> 5; \
            if (r < N_WIN) { const int l = r / IT_WIN; r -= l * IT_WIN; const int kb = r / 73, nb = r % 73; const int db_ = nb < 64 ? nb : (nb == 64 ? 72 : (nb < 73 ? nb - 1 : nb + 7)); \
                Nn_ = DIN; sp_ = args.in[I_WIN] + (size_t)l * 1024 * DIN + (size_t)(64 * kb + kr) * DIN + 32 * nb + 4 * c4; d = WTIN + (size_t)l * NP * 1024 + (size_t)(32 * db_ + n) * 1024 + 64 * kb + 8 * kh; } \
            else { r -= N_WIN; const int mi = r / IT_PROJ; r -= mi * IT_PROJ; const int l = mi >> 2, which = mi & 3; const int kb = r / 32, nb = r % 32; \
                const float* wsrc = which == 0 ? args.in[I_WPSG] : (which == 1 ? args.in[I_WPDN] : (which == 2 ? args.in[I_WPAT] : args.in[I_WOUT])); \
                Nn_ = 1024; sp_ = wsrc + (size_t)l * 1024 * 1024 + (size_t)(64 * kb + kr) * 1024 + 32 * nb + 4 * c4; d = WTPROJ + (size_t)mi * 1024 * 1024 + (size_t)(32 * nb + n) * 1024 + 64 * kb + 8 * kh; } } while (0)
#define P0_ISSUE(v, d, it_) do { P0_DECODE(it_, d); _Pragma("unroll") for (int i_ = 0; i_ < 8; ++i_) v[i_] = *(const f32x4*)(sp_ + (size_t)(8 * i_) * Nn_); asm volatile("" ::: "memory"); __builtin_amdgcn_sched_barrier(0); } while (0)
            P0_ISSUE(va, da, gw); P0_ISSUE(vb, db, gw + NGW);
            for (int it = gw; it < N_CV; it += 3 * NGW) {
                P0_ISSUE(vc, dc, it + 2 * NGW);
                cv_proc(va, da, scr, lane);
                if (it + NGW >= N_CV) break;
                P0_ISSUE(va, da, it + 3 * NGW);
                cv_proc(vb, db, scr, lane);
                if (it + 2 * NGW >= N_CV) break;
                P0_ISSUE(vb, db, it + 4 * NGW);
                cv_proc(vc, dc, scr, lane);
            }
#undef P0_ISSUE
#undef P0_DECODE
        }
        for (int it = gw; it < 2 * 256 * 16; it += NGW) { const int l = it / 4096, r = it % 4096, nb = 73 + (r >> 4), kb = r & 15;
            transpose_item_small8(args.in[I_WIN] + (size_t)l * 1024 * DIN, DIN, 64 * kb, 32 * nb, ws + WS_WTIN8 + (size_t)l * NP * 1024, 32 * (nb + 7), scr, lane); }
        for (int it = gw; it < 2 * 512; it += NGW) { const int l = it >> 9, r = it & 511, nb = r >> 4, kb = r & 15;
            transpose_item_small8(args.in[I_WOUT] + (size_t)l * 1024 * 1024, 1024, 64 * kb, 32 * nb, ws + WS_WOUT8 + (size_t)l * 1024 * 1024, 32 * nb, scr, lane); }
        for (int it = gw; it < 6 * 512; it += NGW) { const int mi = it >> 9, l = mi / 3, which = mi - 3 * l, r = it & 511, nb = r >> 4, kb = r & 15;
            const float* wsrc = which == 0 ? args.in[I_WPSG] : (which == 1 ? args.in[I_WPDN] : args.in[I_WPAT]);
            transpose_item_small8(wsrc + (size_t)l * 1024 * 1024, 1024, 64 * kb, 32 * nb, ws + WS_WPROJ8 + (size_t)mi * 1024 * 1024, 32 * nb, scr, lane); }
        __syncthreads();
        if (bx < 192) {
            LAS float* sc = (LAS float*)lds;
            LAS float* red = (LAS float*)(lds + 9 * 1024 * 4);
            for (int i = tid; i < 9 * 1024; i += 512) { const int s = i >> 10, d = i & 1023; const float cv = s < 8 ? args.in[I_C][s * 1024 + d] : args.in[I_CCTX][d]; sc[i] = siluf_(cv); }
            __syncthreads();
            for (int item = bx; item < 192; item += G) {
                const int l = item / 96, j0 = (item % 96) * 64;
                const int r4 = lane >> 4, c16 = lane & 15;
                const float* wm = args.in[I_WMOD] + (size_t)l * 1024 * 6144 + (size_t)(wave * 128 + r4) * 6144 + j0 + 4 * c16;
                f32x4 a[9];
#pragma unroll
                for (int s = 0; s < 9; ++s) a[s] = (f32x4){0.f, 0.f, 0.f, 0.f};
#pragma unroll 1
                for (int half = 0; half < 2; ++half) {
                    f32x4 wv[16];
#pragma unroll
                    for (int i = 0; i < 16; ++i) wv[i] = *(const f32x4*)(wm + (size_t)(4 * (16 * half + i)) * 6144);
                    asm volatile("" ::: "memory"); __builtin_amdgcn_sched_barrier(0);
#pragma unroll
                    for (int i = 0; i < 16; ++i) { const int d = wave * 128 + 4 * (16 * half + i) + r4;
#pragma unroll
                        for (int s = 0; s < 9; ++s) a[s] += wv[i] * sc[s * 1024 + d]; }
                }
#pragma unroll
                for (int s = 0; s < 9; ++s) {
#pragma unroll
                    for (int k = 0; k < 4; ++k) { float t = a[s][k]; t += __shfl_xor(t, 16); t += __shfl_xor(t, 32); a[s][k] = t; }
                    if (r4 == 0) *(LAS f32x4*)(red + (wave * 9 + s) * 64 + 4 * c16) = a[s]; }
                __syncthreads();
                for (int i = tid; i < 9 * 64; i += 512) { float t = 0.f;
#pragma unroll
                    for (int w = 0; w < 8; ++w) t += red[w * 9 * 64 + i];
                    const int s = i >> 6, j = j0 + (i & 63);
                    MOD[((size_t)l * 9 + s) * 6144 + j] = t + args.in[I_BMOD][l * 6144 + j]; }
                __syncthreads();
            }
        }
    }
    SEAM(0);
    if (EN(1) && IN(1)) { HIDE_TID;
        const int RW1 = (MT + NGW - 1) / NGW, r0 = gw * RW1, r1 = (r0 + RW1) < MT ? (r0 + RW1) : MT;
        if (r0 < r1) {
            f32x4 xv[4], xn[4], gg[4], aa[4], bb[4]; int curslot = -1;
#define P1_ROW(dst, rr) do { const int r_ = (rr) < MT ? (rr) : MT - 1; const float* xr_ = r_ < NL ? args.in[I_X] + (size_t)r_ * D : args.in[I_CTX] + (size_t)(r_ - NL) * D; \
            _Pragma("unroll") for (int j = 0; j < 4; ++j) dst[j] = ((const f32x4*)xr_)[64 * j + lane]; } while (0)
            P1_ROW(xv, r0);
#pragma unroll
            for (int j = 0; j < 4; ++j) gg[j] = ((const f32x4*)args.in[I_NPRE])[64 * j + lane];
            for (int r = r0; r < r1; ++r) {
                P1_ROW(xn, r + 1);
                const int slot = mod_slot(r);
                if (slot != curslot) { curslot = slot; const float* md = MOD + (size_t)slot * 6144;
#pragma unroll
                    for (int j = 0; j < 4; ++j) { bb[j] = ((const f32x4*)md)[64 * j + lane]; aa[j] = ((const f32x4*)(md + 1024))[64 * j + lane]; } }
                asm volatile("" ::: "memory"); __builtin_amdgcn_sched_barrier(0);
                float ss = 0.f;
#pragma unroll
                for (int j = 0; j < 4; ++j) ss += (xv[j].x * xv[j].x + xv[j].y * xv[j].y) + (xv[j].z * xv[j].z + xv[j].w * xv[j].w);
                const float rinv = rsqrtf(wave_sum(ss) * (1.f / D) + EPS);
                bf16* orow = H + (size_t)r * D;
#pragma unroll
                for (int j = 0; j < 4; ++j) { const f32x4 h = xv[j] * rinv * gg[j] * (aa[j] + 1.0f) + bb[j];
                    v2u o; o.x = pk2(h.x, h.y); o.y = pk2(h.z, h.w); ((v2u*)orow)[64 * j + lane] = o;
                    unsigned o8 = __builtin_amdgcn_cvt_pk_fp8_f32(h.x, h.y, 0, false); o8 = __builtin_amdgcn_cvt_pk_fp8_f32(h.z, h.w, o8, true); ((unsigned*)(ws + WS_H8 + (size_t)r * 1024))[64 * j + lane] = o8; }
#pragma unroll
                for (int j = 0; j < 4; ++j) xv[j] = xn[j];
            }
#undef P1_ROW
        }
    }
    SEAM(1);

}

template <int L> __device__ __forceinline__ void layer_body(const KCtx& K, const XcdBarrier& bar) {
    KCTX_LOCALS;
    constexpr int l = L;
    {
        const int pb = 2 + 12 * l;
        const bool ctx_out = (l == 0);
        const int ML = ctx_out ? MT : NL;
        const float* MODL = MOD + (size_t)l * 9 * 6144;
        if (EN(2) && IN(pb + 0)) for (int rep_ = 0; rep_ < NREP(2); ++rep_) { HIDE_TID;
            constexpr int NT8 = (NP - C_DNQ) / 256, NT16 = NP / 256 - NT8;
            { pg8::OrderRect2 S; S.A = (const char*)H; S.Bt = (const char*)(WTIN + (size_t)l * NP * 1024); S.G = G; S.c = bx; S.tile = (size_t)256 * 1024 * 2; S.pn0 = 0;
              if (ctx_out) { S.nM0 = MT / 256; S.nN0 = NT16; S.nM1 = 0; S.nN1 = 0; } else { S.nM0 = NL / 256; S.nN0 = NT16; S.nM1 = NC / 256; S.nN1 = 10; }
              pg8::EpiStoreBf16 E{P, NP, 1.0f};
              pg8::gemm_phase<pg8::EpiStoreBf16, pg8::OrderRect2>(lds, S, E, wave); }
            { pg8::OrderRect2 S; S.A = (const char*)(ws + WS_H8); S.Bt = (const char*)(ws + WS_WTIN8) + (size_t)l * NP * 1024; S.G = G; S.c = bx; S.tile = (size_t)256 * 1024; S.pn0 = NT16;
              S.nM0 = (ctx_out ? MT : NL) / 256; S.nN0 = NT8; S.nM1 = 0; S.nN1 = 0;
              pg8::EpiStoreBf16 E{P, NP, 1.0f / 64.0f};
              pg8::gemm_phase<pg8::EpiStoreBf16, pg8::OrderRect2, false, true>(lds, S, E, wave); }
        }
        SEAM(pb + 0);
        if (EN(3) && IN(pb + 1)) for (int rep_ = 0; rep_ < NREP(3); ++rep_) { HIDE_TID;
            LAS float* rtab = (LAS float*)lds;
            LAS float* cwl = (LAS float*)(lds + 8192);
            { const float* convw = args.in[I_CONVW] + (size_t)l * 5 * 3072;
              for (int i = tid; i < 1024; i += 512) { const int pos = i >> 4, fi = i & 15; float sn, cs; sincosf((float)pos * exp2f(-(float)fi * (13.287712379549449f / 16.0f)), &sn, &cs); rtab[2 * i] = cs; rtab[2 * i + 1] = sn; }
              for (int i = tid; i < 5 * 3072 / 4; i += 512) *(LAS f32x4*)(cwl + 4 * i) = *(const f32x4*)(convw + 4 * i); }
            __syncthreads();
            const int RW = (MT + NGW - 1) / NGW, rw0 = gw * RW, rw1 = (rw0 + RW) < MT ? (rw0 + RW) : MT;
#pragma unroll 1
            for (int part = 0; part < 3; ++part) {
                const int ccol = (part == 0 ? C_DNQ : (part == 1 ? C_DNK : C_DNV)) + 16 * lane;
                bf16* dbase = (part == 0 ? QN : (part == 1 ? KN : VN)) + 16 * lane;
                const LAS float* wp = cwl + part * 1024 + 16 * lane;
                v4u wa[6], wb[6];
#define B_LDROW(slot, rr) do { const int rc_ = (rr) < 0 ? 0 : ((rr) >= MT ? MT - 1 : (rr)); const bf16* src_ = P + (size_t)rc_ * NP + ccol; wa[slot] = *(const v4u*)src_; wb[slot] = *(const v4u*)(src_ + 8); } while (0)
                if (rw0 < rw1) { B_LDROW(0, rw0 - 2); B_LDROW(1, rw0 - 1); B_LDROW(2, rw0); B_LDROW(3, rw0 + 1); B_LDROW(4, rw0 + 2); }
#pragma unroll 1
                for (int r = rw0; r < rw1; ++r) {
                    asm volatile("" ::: "memory");
                    B_LDROW(5, r + 3);
                    asm volatile("" ::: "memory");
                    const bool is_lat = r < NL; const bool full = is_lat || ctx_out;
                    const int b = row_batch(r), t = is_lat ? r - b * SEQ : (r - NL) - b * CTXL, slen = is_lat ? SEQ : CTXL;
                    float y[16];
#pragma unroll
                    for (int i = 0; i < 16; ++i) y[i] = 0.f;
#pragma unroll
                    for (int tap = 0; tap < 5; ++tap) { const int tt = t + tap - 2;
                        if (tt >= 0 && tt < slen) { const v4u xa = wa[tap], xb = wb[tap];
                            const float xv[16] = {bflo(xa.x), bfhi(xa.x), bflo(xa.y), bfhi(xa.y), bflo(xa.z), bfhi(xa.z), bflo(xa.w), bfhi(xa.w), bflo(xb.x), bfhi(xb.x), bflo(xb.y), bfhi(xb.y), bflo(xb.z), bfhi(xb.z), bflo(xb.w), bfhi(xb.w)};
#pragma unroll
                            for (int i4 = 0; i4 < 4; ++i4) { const f32x4 w4 = *(const LAS f32x4*)(wp + tap * 3072 + 4 * i4);
                                y[4 * i4 + 0] += xv[4 * i4 + 0] * w4.x; y[4 * i4 + 1] += xv[4 * i4 + 1] * w4.y; y[4 * i4 + 2] += xv[4 * i4 + 2] * w4.z; y[4 * i4 + 3] += xv[4 * i4 + 3] * w4.w; } } }
                    float ss = 0.f;
#pragma unroll
                    for (int i = 0; i < 16; ++i) { y[i] = siluf_(y[i]); ss += y[i] * y[i]; }
                    if (part < 2) { ss += __shfl_xor(ss, 1); ss += __shfl_xor(ss, 2); ss += __shfl_xor(ss, 4);
                        const float sc = rsqrtf(ss + EPS) * (part == 0 ? 0.08838834764831845f : 1.0f);
#pragma unroll
                        for (int i = 0; i < 16; ++i) y[i] *= sc; }
                    if (part != 0 || full) st16(dbase + (size_t)r * D, y);
#pragma unroll
                    for (int k = 0; k < 5; ++k) { wa[k] = wa[k + 1]; wb[k] = wb[k + 1]; }
                }
#undef B_LDROW
            }
            {
                float lgv[16], lbv[16];
#pragma unroll
                for (int i4 = 0; i4 < 4; ++i4) { const f32x4 a4 = *(const f32x4*)(args.in[I_SGLNG] + l * 1024 + 16 * lane + 4 * i4), b4 = *(const f32x4*)(args.in[I_SGLNB] + l * 1024 + 16 * lane + 4 * i4);
                    lgv[4 * i4] = a4.x; lgv[4 * i4 + 1] = a4.y; lgv[4 * i4 + 2] = a4.z; lgv[4 * i4 + 3] = a4.w; lbv[4 * i4] = b4.x; lbv[4 * i4 + 1] = b4.y; lbv[4 * i4 + 2] = b4.z; lbv[4 * i4 + 3] = b4.w; }
                const float alog_dtb0 = args.in[I_ALOG][l * 16 + (lane & 15)], alog_dtb1 = args.in[I_DTB][l * 16 + (lane & 15)];
                v4u nq[2], nk[2], nu[2], nv[2], ng[6]; unsigned nab;
#define B_RAW(rr) do { const int rc_ = (rr) < MT ? (rr) : MT - 1; const bf16* p_ = P + (size_t)rc_ * NP; \
                    nq[0] = *(const v4u*)(p_ + C_ATQ + 16 * lane); nq[1] = *(const v4u*)(p_ + C_ATQ + 16 * lane + 8); nk[0] = *(const v4u*)(p_ + C_ATK + 16 * (lane & 7)); nk[1] = *(const v4u*)(p_ + C_ATK + 16 * (lane & 7) + 8); \
                    nu[0] = *(const v4u*)(p_ + C_SGU + 16 * lane); nu[1] = *(const v4u*)(p_ + C_SGU + 16 * lane + 8); nv[0] = *(const v4u*)(p_ + C_SGV + 16 * lane); nv[1] = *(const v4u*)(p_ + C_SGV + 16 * lane + 8); \
                    nab = p_[C_DNA + (lane & 31)]; \
                    _Pragma("unroll") for (int g_ = 0; g_ < 3; ++g_) { ng[2 * g_] = *(const v4u*)(p_ + C_GATE + 1024 * g_ + 16 * lane); ng[2 * g_ + 1] = *(const v4u*)(p_ + C_GATE + 1024 * g_ + 16 * lane + 8); } } while (0)
#define B_UNPK(f, a_, b_) do { f[0] = bflo(a_.x); f[1] = bfhi(a_.x); f[2] = bflo(a_.y); f[3] = bfhi(a_.y); f[4] = bflo(a_.z); f[5] = bfhi(a_.z); f[6] = bflo(a_.w); f[7] = bfhi(a_.w); \
                    f[8] = bflo(b_.x); f[9] = bfhi(b_.x); f[10] = bflo(b_.y); f[11] = bfhi(b_.y); f[12] = bflo(b_.z); f[13] = bfhi(b_.z); f[14] = bflo(b_.w); f[15] = bfhi(b_.w); } while (0)
                if (rw0 < rw1) B_RAW(rw0);
                for (int r = rw0; r < rw1; ++r) {
                    const bool is_lat = r < NL; const bool full = is_lat || ctx_out;
                    const int b = row_batch(r), t = is_lat ? r - b * SEQ : (r - NL) - b * CTXL;
                    bf16* pr = P + (size_t)r * NP;
                    const v4u cq0 = nq[0], cq1 = nq[1], ck0 = nk[0], ck1 = nk[1], cu0 = nu[0], cu1 = nu[1], cv0 = nv[0], cv1 = nv[1], cg0 = ng[0], cg1 = ng[1], cg2 = ng[2], cg3 = ng[3], cg4 = ng[4], cg5 = ng[5]; const unsigned cab = nab;
                    asm volatile("" ::: "memory");
                    B_RAW(r + 1);
                    asm volatile("" ::: "memory");
                    if (is_lat) {
                        const int pos = ((lane & 3) < 2) ? (t >> 6) : (t & 63);
                        float cs[16], sn[16];
#pragma unroll
                        for (int i2 = 0; i2 < 8; ++i2) { const f32x4 t4 = *(const LAS f32x4*)(rtab + pos * 32 + 4 * i2); cs[2 * i2] = t4.x; sn[2 * i2] = t4.y; cs[2 * i2 + 1] = t4.z; sn[2 * i2 + 1] = t4.w; }
                        const float sgn = (lane & 1) ? 1.0f : -1.0f;
                        { float q[16], qp[16]; B_UNPK(q, cq0, cq1);
#pragma unroll
                          for (int i = 0; i < 16; ++i) qp[i] = __shfl_xor(q[i], 1);
#pragma unroll
                          for (int i = 0; i < 16; ++i) q[i] = (q[i] * cs[i] + sgn * qp[i] * sn[i]) * 0.125f;
                          st16(pr + C_ATQ + 16 * lane, q); }
                        { float k[16], kp[16]; B_UNPK(k, ck0, ck1);
#pragma unroll
                          for (int i = 0; i < 16; ++i) kp[i] = __shfl_xor(k[i], 1);
#pragma unroll
                          for (int i = 0; i < 16; ++i) k[i] = k[i] * cs[i] + sgn * kp[i] * sn[i];
                          if (lane < 8) st16(pr + C_ATK + 16 * lane, k); }
                    } else if (full) {
                        float q[16]; B_UNPK(q, cq0, cq1);
#pragma unroll
                        for (int i = 0; i < 16; ++i) q[i] *= 0.125f;
                        st16(pr + C_ATQ + 16 * lane, q);
                    }
                    if (lane < 16) LDEC[(size_t)r * 16 + lane] = -fexp(alog_dtb0) * softplusf_(bf1((bf16)cab) + alog_dtb1);
                    else if (lane < 32) BETA[(size_t)r * 16 + lane - 16] = sigmoidf_(bf1((bf16)cab));
                    if (full) {
                        float u[16]; B_UNPK(u, cu0, cu1);
#pragma unroll
                        for (int i = 0; i < 16; ++i) u[i] = gelu_tanh(u[i]);
                        st16(pr + C_SGU + 16 * lane, u);
                        float v[16]; B_UNPK(v, cv0, cv1); float s = 0.f;
#pragma unroll
                        for (int i = 0; i < 16; ++i) { v[i] = gelu_tanh(v[i]); s += v[i]; }
                        const float mean = wave_sum(s) * (1.f / 1024.f); float s2 = 0.f;
#pragma unroll
                        for (int i = 0; i < 16; ++i) { v[i] -= mean; s2 += v[i] * v[i]; }
                        const float rstd = rsqrtf(wave_sum(s2) * (1.f / 1024.f) + EPS);
#pragma unroll
                        for (int i = 0; i < 16; ++i) v[i] = v[i] * rstd * lgv[i] + lbv[i];
                        st16(pr + C_SGV + 16 * lane, v);
                        { float x0[16], x1[16], x2[16]; B_UNPK(x0, cg0, cg1); B_UNPK(x1, cg2, cg3); B_UNPK(x2, cg4, cg5);
#pragma unroll
                          for (int i = 0; i < 16; ++i) { const float e0 = 1.0f + fexp(-__builtin_amdgcn_fmed3f(x0[i], -30.0f, 30.0f)), e1 = 1.0f + fexp(-__builtin_amdgcn_fmed3f(x1[i], -30.0f, 30.0f)), e2 = 1.0f + fexp(-__builtin_amdgcn_fmed3f(x2[i], -30.0f, 30.0f));
                              x0[i] = e1 * frcp(e0); x1[i] = e2 * frcp(e1); x2[i] = frcp(e2); }
                          st16(pr + C_GATE + 16 * lane, x0); st16(pr + C_GATE + 1024 + 16 * lane, x1); st16(pr + C_GATE + 2048 + 16 * lane, x2); }
                    }
                }
#undef B_RAW
#undef B_UNPK
            }
            for (int it = gw; it < (MT / 64) * 2; it += NGW) {
                const int kvh = it & 1, row0 = (it >> 1) * 64; const bool is_lat = row0 < NL;
                const int b = row_batch(row0), t0 = is_lat ? row0 - b * SEQ : (row0 - NL) - b * CTXL;
                const v4u* src = (const v4u*)(P + (size_t)(row0 + lane) * NP + C_ATV + kvh * 64);
                bf16* dst = is_lat ? VTL + ((size_t)(b * 2 + kvh) * 64) * SEQ + t0 + lane : VTC + ((size_t)(b * 2 + kvh) * 64) * CTXL + t0 + lane;
                const int pitch = is_lat ? SEQ : CTXL;
                v4u wj[8];
#pragma unroll
                for (int j = 0; j < 8; ++j) wj[j] = src[j];
                asm volatile("" ::: "memory");
#pragma unroll
                for (int j = 0; j < 8; ++j) { const v4u w = wj[j];
                    dst[(size_t)(8 * j + 0) * pitch] = (bf16)(w.x & 0xffffu); dst[(size_t)(8 * j + 1) * pitch] = (bf16)(w.x >> 16);
                    dst[(size_t)(8 * j + 2) * pitch] = (bf16)(w.y & 0xffffu); dst[(size_t)(8 * j + 3) * pitch] = (bf16)(w.y >> 16);
                    dst[(size_t)(8 * j + 4) * pitch] = (bf16)(w.z & 0xffffu); dst[(size_t)(8 * j + 5) * pitch] = (bf16)(w.z >> 16);
                    dst[(size_t)(8 * j + 6) * pitch] = (bf16)(w.w & 0xffffu); dst[(size_t)(8 * j + 7) * pitch] = (bf16)(w.w >> 16); }
            }
        }
        SEAM(pb + 1);
        if (EN(4) && IN(pb + 2)) for (int rep_ = 0; rep_ < NREP(4); ++rep_) { HIDE_TID;
            {
                LAS float* At = (LAS float*)(lds + (wave & 3) * 32768);
                LAS float* Yl = At + 4096;
                LAS float* gamL = (LAS float*)(lds + MISC_OFF + 4096 + wave * 512);
                LAS float* betL = gamL + 64;
                const int r31 = lane & 31, hh = lane >> 5;
                bf16x8 Kf[2][8], Qf[2][8]; float gam_ld = 0.f, bet_ld = 0.f;
#define DN_LOAD(itx) do { const int it_ = (itx) < DN_ITEMS ? (itx) : DN_ITEMS - 1; const int c_ = it_ % DN_NCH, u_ = it_ / DN_NCH, dir_ = u_ & 1, h_ = (u_ >> 1) & 7, b_ = u_ >> 4; \
        { const int ri_ = dn_row(b_, dir_, c_, lane); gam_ld = LDEC[(size_t)ri_ * 16 + dir_ * 8 + h_]; bet_ld = BETA[(size_t)ri_ * 16 + dir_ * 8 + h_]; } \
        _Pragma("unroll") for (int a_ = 0; a_ < 2; ++a_) { const size_t ro_ = (size_t)dn_row(b_, dir_, c_, 32 * a_ + r31) * D + h_ * 128 + 8 * hh; \
            _Pragma("unroll") for (int ks_ = 0; ks_ < 8; ++ks_) { Kf[a_][ks_] = *(const bf16x8*)(KN + ro_ + 16 * ks_); Qf[a_][ks_] = *(const bf16x8*)(QN + ro_ + 16 * ks_); } } \
        asm volatile("" ::: "memory"); __builtin_amdgcn_sched_barrier(0); } while (0)
                if (wave < 4 && bx * 4 + wave < DN_ITEMS) DN_LOAD(bx * 4 + wave);
                if (wave < 4) for (int it = bx * 4 + wave; it < DN_ITEMS; it += G * 4) {
                    const int c = it % DN_NCH, u = it / DN_NCH, dir = u & 1, h = (u >> 1) & 7, b = u >> 4; (void)c; (void)dir; (void)h; (void)b;
                    float gam = gam_ld, bet = bet_ld;
#pragma unroll
                    for (int o = 1; o < 64; o <<= 1) { const float t = __shfl_up(gam, o); if (lane >= o) gam += t; }
                    const float g63 = __shfl(gam, 63);
                    gamL[lane] = gam; betL[lane] = bet;
                    { float* vr = VEC + (size_t)it * 256; vr[lane] = fexp(gam); vr[64 + lane] = bet; vr[128 + lane] = fexp(g63 - gam); if (lane == 0) vr[192] = fexp(g63); }
                    LDS_WAIT();
#pragma unroll
                    for (int tt = 0; tt < 3; ++tt) { const int a = tt == 2 ? 1 : 0, bq = tt == 0 ? 0 : 1;
                        f32x16 acc;
#pragma unroll
                        for (int i = 0; i < 16; ++i) acc[i] = 0.f;
#pragma unroll
                        for (int ks = 0; ks < 8; ++ks) acc = MFMA32(Kf[a][ks], Kf[bq][ks], acc);
                        const int j = 32 * bq + r31; const float gj = gamL[j], bj = betL[j];
#pragma unroll
                        for (int g4 = 0; g4 < 4; ++g4) { const int i0 = 32 * a + 8 * g4 + 4 * hh; const f32x4 gi = *(const LAS f32x4*)(gamL + i0);
#pragma unroll
                            for (int e = 0; e < 4; ++e) { const int i = i0 + e; At[i * 64 + j] = (j > i) ? bj * fexp(gj - gi[e]) * acc[4 * g4 + e] : 0.f; } }
                        asm volatile("" ::: "memory"); }
                    asm volatile("" ::: "memory");
                    {
#pragma unroll
                        for (int tt = 0; tt < 3; ++tt) { const int jt = tt == 2 ? 1 : 0, iq = tt == 0 ? 0 : 1;
                            f32x16 acc;
#pragma unroll
                            for (int i = 0; i < 16; ++i) acc[i] = 0.f;
#pragma unroll
                            for (int ks = 0; ks < 8; ++ks) acc = MFMA32(Kf[jt][ks], Qf[iq][ks], acc);
                            const int i = 32 * iq + r31; const float gi = gamL[i];
#pragma unroll
                            for (int g4 = 0; g4 < 4; ++g4) { const int j0 = 32 * jt + 8 * g4 + 4 * hh; const f32x4 gj = *(const LAS f32x4*)(gamL + j0);
#pragma unroll
                                for (int e = 0; e < 4; ++e) { const int j = j0 + e; acc[4 * g4 + e] = (i >= j) ? fexp(gi - gj[e]) * acc[4 * g4 + e] : 0.f; } }
#pragma unroll
                            for (int sq = 0; sq < 2; ++sq) { const bf16x8 f = pack_frag(acc, sq);
                                *(bf16x8*)(QKREC + (size_t)it * 6144 + (tt * 2 + sq) * 1024 + lane * 16) = f; }
                            asm volatile("" ::: "memory"); }
                    }
                    LDS_WAIT();
                    DN_LOAD(it + G * 4);
                    {
                        const int rb = 32 * hh;
                        { LAS float* z = Yl + (32 + (lane >> 1)) * 64 + 16 * (lane & 1);
                          const f32x4 z4 = (f32x4){0.f, 0.f, 0.f, 0.f}; *(LAS f32x4*)z = z4; *(LAS f32x4*)(z + 4) = z4; *(LAS f32x4*)(z + 8) = z4; *(LAS f32x4*)(z + 12) = z4; }
#pragma unroll 1
                        for (int ib = 7; ib >= 0; --ib) {
                            float y0 = (r31 == 4 * ib) ? 1.0f : 0.0f, y1 = (r31 == 4 * ib + 1) ? 1.0f : 0.0f, y2 = (r31 == 4 * ib + 2) ? 1.0f : 0.0f, y3 = (r31 == 4 * ib + 3) ? 1.0f : 0.0f;
                            const LAS float* ar = At + (rb + 4 * ib) * 64 + rb;
#pragma unroll 2
                            for (int jg = ib + 1; jg < 8; ++jg) { const LAS float* yp = Yl + (rb + 4 * jg) * 64 + lane; const float q0 = yp[0], q1 = yp[64], q2 = yp[128], q3 = yp[192];
                                const f32x4 c0 = *(const LAS f32x4*)(ar + 4 * jg), c1 = *(const LAS f32x4*)(ar + 64 + 4 * jg), c2 = *(const LAS f32x4*)(ar + 128 + 4 * jg), c3 = *(const LAS f32x4*)(ar + 192 + 4 * jg);
                                y0 -= c0.x * q0 + c0.y * q1 + c0.z * q2 + c0.w * q3; y1 -= c1.x * q0 + c1.y * q1 + c1.z * q2 + c1.w * q3;
                                y2 -= c2.x * q0 + c2.y * q1 + c2.z * q2 + c2.w * q3; y3 -= c3.x * q0 + c3.y * q1 + c3.z * q2 + c3.w * q3; }
                            { const f32x4 d0 = *(const LAS f32x4*)(ar + 4 * ib), d1 = *(const LAS f32x4*)(ar + 64 + 4 * ib), d2 = *(const LAS f32x4*)(ar + 128 + 4 * ib);
                              y2 -= d2.w * y3; y1 -= d1.z * y2 + d1.w * y3; y0 -= d0.y * y1 + d0.z * y2 + d0.w * y3; }
                            LAS float* yo = Yl + (rb + 4 * ib) * 64 + lane; yo[0] = y0; yo[64] = y1; yo[128] = y2; yo[192] = y3;
                        }
                        asm volatile("" ::: "memory");
                        f32x16 wacc;
#pragma unroll
                        for (int i = 0; i < 16; ++i) wacc[i] = 0.f;
#pragma unroll
                        for (int sq = 0; sq < 2; ++sq) {
                            const LAS float* ua = At + r31 * 64 + 32 + 16 * sq + 8 * hh; const f32x4 u0 = *(const LAS f32x4*)ua, u1 = *(const LAS f32x4*)(ua + 4);
                            const LAS float* yb = Yl + (32 + 16 * sq + 8 * hh) * 64 + 32 + r31;
                            v4u pa, pb; pa.x = pk2(u0.x, u0.y); pa.y = pk2(u0.z, u0.w); pa.z = pk2(u1.x, u1.y); pa.w = pk2(u1.z, u1.w);
                            pb.x = pk2(yb[0], yb[64]); pb.y = pk2(yb[128], yb[192]); pb.z = pk2(yb[256], yb[320]); pb.w = pk2(yb[384], yb[448]);
                            wacc = MFMA32(__builtin_bit_cast(bf16x8, pa), __builtin_bit_cast(bf16x8, pb), wacc); }
                        f32x16 yacc;
#pragma unroll
                        for (int i = 0; i < 16; ++i) yacc[i] = 0.f;
#pragma unroll
                        for (int sq = 0; sq < 2; ++sq) {
                            const LAS float* ya = Yl + r31 * 64 + 16 * sq + 4 * hh; const f32x4 a0 = *(const LAS f32x4*)ya, a1 = *(const LAS f32x4*)(ya + 8);
                            v4u pa; pa.x = pk2(a0.x, a0.y); pa.y = pk2(a0.z, a0.w); pa.z = pk2(a1.x, a1.y); pa.w = pk2(a1.z, a1.w);
                            const bf16x8 wf = pack_frag(wacc, sq);
                            yacc = MFMA32(__builtin_bit_cast(bf16x8, pa), wf, yacc); }
#pragma unroll
                        for (int g4 = 0; g4 < 4; ++g4)
#pragma unroll
                            for (int e = 0; e < 4; ++e) Yl[(8 * g4 + 4 * hh + e) * 64 + 32 + r31] = -yacc[4 * g4 + e];
                        asm volatile("" ::: "memory");
                    }
                    { LAS unsigned char* Tl = (LAS unsigned char*)At + lane * 144;
#pragma unroll 2
                      for (int q8 = 0; q8 < 8; ++q8) { const LAS float* yp = Yl + (8 * q8) * 64 + lane;
                          v4u w; w.x = pk2(yp[0], yp[64]); w.y = pk2(yp[128], yp[192]); w.z = pk2(yp[256], yp[320]); w.w = pk2(yp[384], yp[448]);
                          *(LAS v4u*)(Tl + 16 * q8) = w; } }
                    LDS_WAIT();
#pragma unroll
                    for (int f = 0; f < 6; ++f) { const int mt = f < 2 ? 0 : 1, ks = f < 2 ? f : f - 2;
                        const LAS unsigned char* src = (const LAS unsigned char*)At + (32 * mt + r31) * 144 + 2 * (32 * (ks >> 1) + 16 * (ks & 1) + 4 * hh);
                        const v2u lo = *(const LAS v2u*)src, hi = *(const LAS v2u*)(src + 16);
                        *(v4u*)(TREC + (size_t)it * 6144 + f * 1024 + lane * 16) = (v4u){lo.x, lo.y, hi.x, hi.y}; }
                    LDS_WAIT();
                }
#undef DN_LOAD
                {
                    LAS float* scr = wave < 4 ? (LAS float*)(lds + wave * 32768) : (LAS float*)(lds + MISC_OFF + 6144) + (wave - 4) * 544;
                    LAS unsigned* cvq = (LAS unsigned*)(lds + MISC_OFF + 448);
                    const int cv_rem = (ML / 256 * 4) % G, cv_short = cv_rem ? G - cv_rem : 0, cv_n1 = CV_N_TOT - (CV_E_QUOTA + CV_F_QUOTA) * 8 * cv_short;
                    for (;;) { unsigned m = 0; if (lane == 0) m = atomicAdd((unsigned*)cvq, 1u); m = (unsigned)__builtin_amdgcn_readfirstlane((int)m);
                        const int it = bx + G * (int)m; if (it >= cv_n1) break;
                        expert_item(it, l, args.in[I_WGU], args.in[I_WDN], WTGU, WTDN, scr, lane); }
                }
            }
            __syncthreads();
            if (tid == 0) *(LAS unsigned*)(lds + MISC_OFF + 448) = 0u;
            __syncthreads();
        }
        SEAM(pb + 2);
        if (EN(5) && IN(pb + 3)) for (int rep_ = 0; rep_ < NREP(5); ++rep_) { HIDE_TID;
            for (int unit = bx; unit < 128; unit += G) {
                const int b = unit >> 4, h = (unit >> 1) & 7, dir = unit & 1;
                constexpr int BUF = 63488, O_K = 0, O_Q = 16384, O_T = 32768, O_QK = 38912, O_VEC = 45056, O_V = 46080, VP = 272;
                const size_t item0 = (size_t)unit * DN_NCH;
                __syncthreads();
                if (wave >= 4) {
                    const int lt = lane_fresh() + 64 * (wave - 4);
                    v4u kv[4], qv[4], rv[4], wv[4];
#define DN_PIECE(k4) const int p = lt + 256 * (k4), i = 16 * ((p >> 6) & 3) + (p & 15), q = 4 * (p >> 8) + ((p >> 4) & 3)
#define DN_LOAD(cc) do { _Pragma("unroll") for (int k4 = 0; k4 < 4; ++k4) { DN_PIECE(k4); const size_t ro = (size_t)dn_row(b, dir, (cc), i) * D + h * 128 + 8 * q; \
                            kv[k4] = *(const v4u*)(KN + ro); qv[k4] = *(const v4u*)(QN + ro); wv[k4] = *(const v4u*)(VN + ro); \
                            const int pr = lt + 256 * k4; const unsigned char* rs = pr < 384 ? TREC + (item0 + (cc)) * 6144 + pr * 16 : (pr < 768 ? QKREC + (item0 + (cc)) * 6144 + (pr - 384) * 16 : (const unsigned char*)(VEC + (item0 + (cc)) * 256) + (pr - 768) * 16); \
                            if (pr < 832) rv[k4] = *(const v4u*)rs; } } while (0)
#define DN_WRITE(bufp) do { _Pragma("unroll") for (int k4 = 0; k4 < 4; ++k4) { DN_PIECE(k4); \
                            { const int mt = i >> 5, r = i & 31, ks = q >> 1; LAS unsigned char* d0 = (bufp) + ((mt * 8 + ks) * 64 + r) * 16 + 8 * (q & 1); \
                              *(LAS v2u*)(d0 + O_K) = (v2u){kv[k4].x, kv[k4].y}; *(LAS v2u*)(d0 + O_K + 512) = (v2u){kv[k4].z, kv[k4].w}; \
                              *(LAS v2u*)(d0 + O_Q) = (v2u){qv[k4].x, qv[k4].y}; *(LAS v2u*)(d0 + O_Q + 512) = (v2u){qv[k4].z, qv[k4].w}; \
                              *(LAS v4u*)((bufp) + O_V + i * VP + 16 * q) = wv[k4]; } \
                            const int pr = lt + 256 * k4; if (pr < 832) *(LAS v4u*)((bufp) + O_T + pr * 16) = rv[k4]; } } while (0)
                    DN_LOAD(0); DN_WRITE(lds); DN_LOAD(1); LDS_WAIT();
                    __builtin_amdgcn_s_barrier(); asm volatile("" ::: "memory");
                    for (int c = 0; c < DN_NCH; ++c) {
                        if (c + 1 < DN_NCH) { DN_WRITE(lds + ((c + 1) & 1) * BUF); }
                        if (c + 2 < DN_NCH) { DN_LOAD(c + 2); }
                        LDS_WAIT();
                        __builtin_amdgcn_s_barrier(); asm volatile("" ::: "memory");
                    }
#undef DN_LOAD
#undef DN_WRITE
#undef DN_PIECE
                } else {
                    const int n = wave;
                    f32x16 S[4];
#pragma unroll
                    for (int kt = 0; kt < 4; ++kt)
#pragma unroll
                        for (int i = 0; i < 16; ++i) S[kt][i] = 0.f;
                    __builtin_amdgcn_s_barrier(); asm volatile("" ::: "memory");
                    for (int c = 0; c < DN_NCH; ++c) {
                        const int lane = lane_fresh(), r31 = lane & 31, hh = lane >> 5;
                        const LAS unsigned char* buf = lds + (c & 1) * BUF;
                        const unsigned fba = (unsigned)(size_t)buf + (unsigned)(lane * 16);
                        const bool want_o = (c >= 4) || ctx_out;
                        unsigned vv[16];
                        { const unsigned va = (unsigned)(size_t)(buf + O_V) + (unsigned)(4 * hh * VP + (32 * n + r31) * 2);
                          unsigned vl[16], vh[16];
#define VO(i) (((i) & 3) + 8 * ((i) >> 2)) * 272
#define VRD16(arr, base) asm volatile("ds_read_u16 %0, %16 offset:%17\n\tds_read_u16 %1, %16 offset:%18\n\tds_read_u16 %2, %16 offset:%19\n\tds_read_u16 %3, %16 offset:%20\n\t" \
                                       "ds_read_u16 %4, %16 offset:%21\n\tds_read_u16 %5, %16 offset:%22\n\tds_read_u16 %6, %16 offset:%23\n\tds_read_u16 %7, %16 offset:%24\n\t" \
                                       "ds_read_u16 %8, %16 offset:%25\n\tds_read_u16 %9, %16 offset:%26\n\tds_read_u16 %10, %16 offset:%27\n\tds_read_u16 %11, %16 offset:%28\n\t" \
                                       "ds_read_u16 %12, %16 offset:%29\n\tds_read_u16 %13, %16 offset:%30\n\tds_read_u16 %14, %16 offset:%31\n\tds_read_u16 %15, %16 offset:%32\n\ts_waitcnt lgkmcnt(0)" \
                                       : "=&v"(arr[0]), "=&v"(arr[1]), "=&v"(arr[2]), "=&v"(arr[3]), "=&v"(arr[4]), "=&v"(arr[5]), "=&v"(arr[6]), "=&v"(arr[7]), "=&v"(arr[8]), "=&v"(arr[9]), "=&v"(arr[10]), "=&v"(arr[11]), "=&v"(arr[12]), "=&v"(arr[13]), "=&v"(arr[14]), "=&v"(arr[15]) \
                                       : "v"(va), "n"(VO(0) + (base)), "n"(VO(1) + (base)), "n"(VO(2) + (base)), "n"(VO(3) + (base)), "n"(VO(4) + (base)), "n"(VO(5) + (base)), "n"(VO(6) + (base)), "n"(VO(7) + (base)), \
                                         "n"(VO(8) + (base)), "n"(VO(9) + (base)), "n"(VO(10) + (base)), "n"(VO(11) + (base)), "n"(VO(12) + (base)), "n"(VO(13) + (base)), "n"(VO(14) + (base)), "n"(VO(15) + (base)) : "memory")
                          VRD16(vl, 0); VRD16(vh, 32 * 272);
#undef VRD16
#undef VO
#pragma unroll
                          for (int i = 0; i < 16; ++i) vv[i] = vl[i] | (vh[i] << 16);
                        }
                        const LAS float* vec = (const LAS float*)(buf + O_VEC);
                        bf16x8 Sf[8];
#pragma unroll
                        for (int kt = 0; kt < 4; ++kt) { Sf[2 * kt] = pack_frag(S[kt], 0); Sf[2 * kt + 1] = pack_frag(S[kt], 1); }
                        asm volatile("" ::: "memory");
                        f32x16 X[2];
#pragma unroll
                        for (int mt = 0; mt < 2; ++mt) {
#pragma unroll
                            for (int i = 0; i < 16; ++i) X[mt][i] = 0.f;
                            { bf16x8 af[8]; if (mt == 0) LDFRAG8(af, fba, O_K); else LDFRAG8(af, fba, O_K + 8192);
#pragma unroll
                              for (int ks = 0; ks < 8; ++ks) X[mt] = MFMA32(af[ks], Sf[ks], X[mt]); } }
#pragma unroll
                        for (int mt = 0; mt < 2; ++mt)
#pragma unroll
                            for (int g4 = 0; g4 < 4; ++g4) { const int i0 = 32 * mt + 8 * g4 + 4 * hh; const f32x4 eg = *(const LAS f32x4*)(vec + i0), bt = *(const LAS f32x4*)(vec + 64 + i0);
#pragma unroll
                                for (int e = 0; e < 4; ++e) { const float vval = mt == 0 ? bflo(vv[4 * g4 + e]) : bfhi(vv[4 * g4 + e]); X[mt][4 * g4 + e] = bt[e] * (vval - eg[e] * X[mt][4 * g4 + e]); } }
                        asm volatile("" ::: "memory");
                        bf16x8 Rf[4];
#pragma unroll
                        for (int mt = 0; mt < 2; ++mt) { Rf[2 * mt] = pack_frag(X[mt], 0); Rf[2 * mt + 1] = pack_frag(X[mt], 1); }
                        f32x16 U[2];
#pragma unroll
                        for (int mt = 0; mt < 2; ++mt)
#pragma unroll
                            for (int i = 0; i < 16; ++i) U[mt][i] = 0.f;
                        { bf16x8 tf[6]; LDFRAG6(tf, fba, O_T);
                          U[0] = MFMA32(tf[0], Rf[0], U[0]); U[1] = MFMA32(tf[2], Rf[0], U[1]); U[0] = MFMA32(tf[1], Rf[1], U[0]); U[1] = MFMA32(tf[3], Rf[1], U[1]);
                          U[1] = MFMA32(tf[4], Rf[2], U[1]); U[1] = MFMA32(tf[5], Rf[3], U[1]); }
                        asm volatile("" ::: "memory");
                        bf16x8 Uf[4], Ue[4];
#pragma unroll
                        for (int mt = 0; mt < 2; ++mt) { Uf[2 * mt] = pack_frag(U[mt], 0); Uf[2 * mt + 1] = pack_frag(U[mt], 1); }
#pragma unroll
                        for (int mt = 0; mt < 2; ++mt)
#pragma unroll
                            for (int g4 = 0; g4 < 4; ++g4) { const int i0 = 32 * mt + 8 * g4 + 4 * hh; const f32x4 ee = *(const LAS f32x4*)(vec + 128 + i0);
#pragma unroll
                                for (int e = 0; e < 4; ++e) U[mt][4 * g4 + e] *= ee[e]; }
#pragma unroll
                        for (int mt = 0; mt < 2; ++mt) { Ue[2 * mt] = pack_frag(U[mt], 0); Ue[2 * mt + 1] = pack_frag(U[mt], 1); }
                        asm volatile("" ::: "memory");
                        if (want_o) {
#pragma unroll
                            for (int mt = 0; mt < 2; ++mt) {
                                f32x16 Oa;
#pragma unroll
                                for (int i = 0; i < 16; ++i) Oa[i] = 0.f;
                                { bf16x8 af[8]; if (mt == 0) LDFRAG8(af, fba, O_Q); else LDFRAG8(af, fba, O_Q + 8192);
#pragma unroll
                                  for (int ks = 0; ks < 8; ++ks) Oa = MFMA32(af[ks], Sf[ks], Oa); }
#pragma unroll
                                for (int g4 = 0; g4 < 4; ++g4) { const int i0 = 32 * mt + 8 * g4 + 4 * hh; const f32x4 eg = *(const LAS f32x4*)(vec + i0);
#pragma unroll
                                    for (int e = 0; e < 4; ++e) Oa[4 * g4 + e] *= eg[e]; }
#pragma unroll
                                for (int sq = 0; sq < 2; ++sq) {
                                    if (mt == 0) Oa = MFMA32(*(const LAS bf16x8*)(buf + O_QK + ((0 + sq) * 64 + lane) * 16), Uf[sq], Oa);
                                    else { Oa = MFMA32(*(const LAS bf16x8*)(buf + O_QK + ((2 + sq) * 64 + lane) * 16), Uf[sq], Oa);
                                           Oa = MFMA32(*(const LAS bf16x8*)(buf + O_QK + ((4 + sq) * 64 + lane) * 16), Uf[2 + sq], Oa); } }
#pragma unroll
                                for (int i = 0; i < 16; ++i) { const int ti = 32 * mt + (i & 3) + 8 * (i >> 2) + 4 * hh;
                                    ODN[((size_t)dir * MT + dn_row(b, dir, c, ti)) * D + h * 128 + 32 * n + r31] = (bf16)f2bf(Oa[i]); }
                                __builtin_amdgcn_sched_barrier(0);
                            }
                        }
                        asm volatile("" ::: "memory");
                        { const float cd = vec[192];
                          const int i16 = lane & 15, qq = i16 >> 2, pp = i16 & 3, gb = (lane >> 4) & 1;
                          const unsigned tra = (unsigned)(size_t)(buf + O_K) + (unsigned)((gb * 64 + (pp & 1) * 32 + 4 * hh + qq) * 16 + 8 * (pp >> 1));
#pragma unroll
                          for (int kt = 0; kt < 4; ++kt) {
#pragma unroll
                              for (int i = 0; i < 16; ++i) S[kt][i] *= cd;
                              v2u t0, t1, t2, t3, t4, t5, t6, t7;
#define TRO(ks, sec) ((((ks) >> 1) * 8 + 2 * kt) * 1024 + (16 * ((ks) & 1) + 8 * (sec)) * 16)
                              asm volatile("ds_read_b64_tr_b16 %0, %8 offset:%9\n\tds_read_b64_tr_b16 %1, %8 offset:%10\n\tds_read_b64_tr_b16 %2, %8 offset:%11\n\tds_read_b64_tr_b16 %3, %8 offset:%12\n\t"
                                           "ds_read_b64_tr_b16 %4, %8 offset:%13\n\tds_read_b64_tr_b16 %5, %8 offset:%14\n\tds_read_b64_tr_b16 %6, %8 offset:%15\n\tds_read_b64_tr_b16 %7, %8 offset:%16\n\ts_waitcnt lgkmcnt(0)"
                                           : "=&v"(t0), "=&v"(t1), "=&v"(t2), "=&v"(t3), "=&v"(t4), "=&v"(t5), "=&v"(t6), "=&v"(t7)
                                           : "v"(tra), "n"(TRO(0, 0)), "n"(TRO(0, 1)), "n"(TRO(1, 0)), "n"(TRO(1, 1)), "n"(TRO(2, 0)), "n"(TRO(2, 1)), "n"(TRO(3, 0)), "n"(TRO(3, 1)) : "memory");
#undef TRO
                              S[kt] = MFMA32(__builtin_bit_cast(bf16x8, (v4u){t0.x, t0.y, t1.x, t1.y}), Ue[0], S[kt]);
                              S[kt] = MFMA32(__builtin_bit_cast(bf16x8, (v4u){t2.x, t2.y, t3.x, t3.y}), Ue[1], S[kt]);
                              S[kt] = MFMA32(__builtin_bit_cast(bf16x8, (v4u){t4.x, t4.y, t5.x, t5.y}), Ue[2], S[kt]);
                              S[kt] = MFMA32(__builtin_bit_cast(bf16x8, (v4u){t6.x, t6.y, t7.x, t7.y}), Ue[3], S[kt]); } }
                        LDS_WAIT();
                        __builtin_amdgcn_s_barrier(); asm volatile("" ::: "memory");
                    }
                }
            }
            __syncthreads();
            {
                LAS unsigned char* Ks = lds;
                LAS unsigned char* Vt = lds + 49152;
                volatile LAS unsigned* qslot = (volatile LAS unsigned*)(lds + MISC_OFF + 256);
                const int nit = 512 + (ctx_out ? 32 : 0);
                const int r31 = lane & 31, hh = lane >> 5;
                for (int arep_ = 0; arep_ < NREP(14); ++arep_) for (;;) {
                    if (tid == 0) *qslot = __hip_atomic_fetch_add(ctl + CW_ATTQ + 64 * (l + 2 * arep_), 1u, __ATOMIC_RELAXED, __HIP_MEMORY_SCOPE_AGENT);
                    __syncthreads();
                    const int it = __builtin_amdgcn_readfirstlane((int)*qslot);
                    __syncthreads();
                    if (it >= nit) break;
                    const bool is_lat = it < 512;
                    const int b = is_lat ? it >> 6 : (it - 512) >> 2, nbk = is_lat ? (it >> 1) & 31 : ((it - 512) >> 1) & 1, kvh = it & 1;
                    const int q0 = nbk * 128, qrow0 = is_lat ? b * SEQ + q0 : NL + b * CTXL + q0, head = kvh * 8 + wave;
                    f32x16 O[4][2]; float mrow[4], lrow[4];
                    { const float sink = args.in[I_SINK][l * 16 + head];
#pragma unroll
                      for (int qt = 0; qt < 4; ++qt) { mrow[qt] = sink; lrow[qt] = 1.0f;
#pragma unroll
                          for (int dt = 0; dt < 2; ++dt)
#pragma unroll
                              for (int i = 0; i < 16; ++i) O[qt][dt][i] = 0.f; } }
                    const int nseg = is_lat ? 2 : 1;
                    for (int seg = 0; seg < nseg; ++seg) {
                        const int nk = seg == 0 ? 256 : 384, tbase = seg == 0 ? 0 : q0 - 128, tlim = seg == 0 ? CTXL : SEQ;
                        const int krow0 = seg == 0 ? NL + b * CTXL : b * SEQ;
                        const bf16* vsrc = seg == 0 ? VTC + ((size_t)(b * 2 + kvh) * 64) * CTXL : VTL + ((size_t)(b * 2 + kvh) * 64) * SEQ;
                        __syncthreads();
                        for (int p = tid; p < nk * 8; p += 512) { const int key = p >> 3, c = p & 7, tk = tbase + key;
                            v4u val = (v4u){0u, 0u, 0u, 0u};
                            if (tk >= 0 && tk < tlim) val = *(const v4u*)(P + (size_t)(krow0 + tk) * NP + C_ATK + kvh * 64 + 8 * c);
                            *(LAS v4u*)(Ks + key * 128 + 16 * (c ^ ((key >> 1) & 7))) = val; }
                        { const int ppd = nk >> 2;
                          for (int p = tid; p < 64 * ppd; p += 512) { const int dim = p / ppd, i = p - dim * ppd, tk = tbase + 4 * i;
                              v2u val = (v2u){0u, 0u};
                              if (tk >= 0 && tk < tlim) val = *(const v2u*)(vsrc + (size_t)dim * tlim + tk);
                              *(LAS v2u*)(Vt + dim * 776 + 8 * i) = val; } }
                        __syncthreads();
#pragma unroll
                        for (int qt = 0; qt < 4; ++qt) {
                            bf16x8 qf[4];
                            { const bf16* qg = P + (size_t)(qrow0 + 32 * qt + r31) * NP + C_ATQ + head * 64 + 8 * hh;
#pragma unroll
                              for (int sp = 0; sp < 4; ++sp) qf[sp] = *(const bf16x8*)(qg + 16 * sp); }
                            const int ntile = seg == 0 ? 8 : 9;
#pragma unroll 1
                            for (int w = 0; w < ntile; ++w) {
                                const int kb = seg == 0 ? 32 * w : 32 * (qt + w);
                                if (seg == 1) { const int tk0 = tbase + kb; if (tk0 < 0 || tk0 >= SEQ) continue; }
                                f32x16 sa;
#pragma unroll
                                for (int i = 0; i < 16; ++i) sa[i] = 0.f;
                                bf16x8 kf[4]; v2u vf[8];
                                { const int key = kb + r31; const int sw = (key >> 1) & 7; const unsigned kp = (unsigned)(size_t)Ks + (unsigned)(key * 128);
                                  const unsigned ka0 = kp + 16 * ((0 + hh) ^ sw), ka1 = kp + 16 * ((2 + hh) ^ sw), ka2 = kp + 16 * ((4 + hh) ^ sw), ka3 = kp + 16 * ((6 + hh) ^ sw);
                                  const unsigned va = (unsigned)(size_t)Vt + (unsigned)(r31 * 776 + 2 * (kb + 4 * hh));
                                  asm volatile("ds_read_b128 %0, %12\n\tds_read_b128 %1, %13\n\tds_read_b128 %2, %14\n\tds_read_b128 %3, %15\n\t"
                                               "ds_read_b64 %4, %16\n\tds_read_b64 %5, %16 offset:16\n\tds_read_b64 %6, %16 offset:32\n\tds_read_b64 %7, %16 offset:48\n\t"
                                               "ds_read_b64 %8, %16 offset:24832\n\tds_read_b64 %9, %16 offset:24848\n\tds_read_b64 %10, %16 offset:24864\n\tds_read_b64 %11, %16 offset:24880\n\ts_waitcnt lgkmcnt(0)"
                                               : "=&v"(kf[0]), "=&v"(kf[1]), "=&v"(kf[2]), "=&v"(kf[3]), "=&v"(vf[0]), "=&v"(vf[1]), "=&v"(vf[2]), "=&v"(vf[3]), "=&v"(vf[4]), "=&v"(vf[5]), "=&v"(vf[6]), "=&v"(vf[7])
                                               : "v"(ka0), "v"(ka1), "v"(ka2), "v"(ka3), "v"(va) : "memory");
#pragma unroll
                                  for (int sp = 0; sp < 4; ++sp) sa = __builtin_amdgcn_mfma_f32_32x32x16_bf16(kf[sp], qf[sp], sa, 0, 0, 0); }
                                if (seg == 1 && (w == 0 || w == 8)) {
#pragma unroll
                                    for (int i = 0; i < 16; ++i) { const int kr = (i & 3) + 8 * (i >> 2) + 4 * hh; const bool keep = (w == 0) ? (kr >= r31) : (kr <= r31); sa[i] = keep ? sa[i] : -INFINITY; } }
                                float mx = sa[0];
#pragma unroll
                                for (int i = 1; i < 16; ++i) mx = fmaxf(mx, sa[i]);
                                mx = fmaxf(mx, __shfl_xor(mx, 32));
                                const float mnew = fmaxf(mrow[qt], mx), alpha = fexp(mrow[qt] - mnew);
                                float rs = 0.f;
#pragma unroll
                                for (int i = 0; i < 16; ++i) { sa[i] = fexp(sa[i] - mnew); rs += sa[i]; }
                                rs += __shfl_xor(rs, 32);
                                lrow[qt] = lrow[qt] * alpha + rs; mrow[qt] = mnew;
                                if (__builtin_amdgcn_ballot_w64(alpha != 1.0f) != 0ull) {
#pragma unroll
                                    for (int dt = 0; dt < 2; ++dt)
#pragma unroll
                                        for (int i = 0; i < 16; ++i) O[qt][dt][i] *= alpha; }
                                bf16x8 pf[2];
#pragma unroll
                                for (int s2 = 0; s2 < 2; ++s2) { v4u pk;
                                    asm volatile("v_cvt_pk_bf16_f32 %0, %4, %5\n\tv_cvt_pk_bf16_f32 %1, %6, %7\n\tv_cvt_pk_bf16_f32 %2, %8, %9\n\tv_cvt_pk_bf16_f32 %3, %10, %11\n\ts_nop 1"
                                                 : "=&v"(pk[0]), "=&v"(pk[1]), "=&v"(pk[2]), "=&v"(pk[3])
                                                 : "v"(sa[8 * s2]), "v"(sa[8 * s2 + 1]), "v"(sa[8 * s2 + 2]), "v"(sa[8 * s2 + 3]), "v"(sa[8 * s2 + 4]), "v"(sa[8 * s2 + 5]), "v"(sa[8 * s2 + 6]), "v"(sa[8 * s2 + 7]));
                                    pf[s2] = __builtin_bit_cast(bf16x8, pk); }
#pragma unroll
                                for (int dt = 0; dt < 2; ++dt)
#pragma unroll
                                    for (int s2 = 0; s2 < 2; ++s2) { const v2u vlo = vf[4 * dt + 2 * s2], vhi = vf[4 * dt + 2 * s2 + 1];
                                        const v4u vv = (v4u){vlo.x, vlo.y, vhi.x, vhi.y};
                                        O[qt][dt] = __builtin_amdgcn_mfma_f32_32x32x16_bf16(__builtin_bit_cast(bf16x8, vv), pf[s2], O[qt][dt], 0, 0, 0); }
                            }
                        }
                    }
#pragma unroll
                    for (int qt = 0; qt < 4; ++qt) { const float inv = frcp(lrow[qt]);
                        unsigned char* yo = (unsigned char*)Y3 + (size_t)2 * MT * D + (size_t)(qrow0 + 32 * qt + r31) * D + head * 64 + 4 * hh;
#pragma unroll
                        for (int dt = 0; dt < 2; ++dt)
#pragma unroll
                            for (int g = 0; g < 4; ++g) { unsigned o = __builtin_amdgcn_cvt_pk_fp8_f32(O[qt][dt][4 * g + 0] * inv, O[qt][dt][4 * g + 1] * inv, 0, false); o = __builtin_amdgcn_cvt_pk_fp8_f32(O[qt][dt][4 * g + 2] * inv, O[qt][dt][4 * g + 3] * inv, o, true);
                                *(unsigned*)(yo + 32 * dt + 8 * g) = o; } }
                }
            }
            __syncthreads();
            {
                constexpr int WPI = 272, VPI = 320;
                LAS unsigned char* Wl = lds; LAS unsigned char* Vl = lds + 128 * WPI;
                const int nchunks = ML / 128, nit = nchunks * 8;
                const int r31 = lane & 31, hh = lane >> 5, pt = wave >> 1, ct0 = 2 * (wave & 1);
                volatile LAS unsigned* qslot2 = (volatile LAS unsigned*)(lds + MISC_OFF + 320);
                for (;;) {
                    __syncthreads();
                    if (tid == 0) *qslot2 = __hip_atomic_fetch_add(ctl + CW_ATTQ + 64 * (4 + l), 1u, __ATOMIC_RELAXED, __HIP_MEMORY_SCOPE_AGENT);
                    __syncthreads();
                    const int it = __builtin_amdgcn_readfirstlane((int)*qslot2);
                    if (it >= nit) break;
                    const int ci = it >> 3, g = it & 7, r0 = ci * 128;
                    const float* wg = args.in[I_SGW] + ((size_t)l * 8 + g) * 128 * 128;
                    __syncthreads();
#pragma unroll
                    for (int k = 0; k < 8; ++k) { const int p = tid + 512 * k, prow = p >> 5, q4 = p & 31; const f32x4 w = *(const f32x4*)(wg + prow * 128 + 4 * q4);
                        *(LAS v2u*)(Wl + prow * WPI + 8 * q4) = (v2u){pk2(w.x, w.y), pk2(w.z, w.w)}; }
#pragma unroll
                    for (int k = 0; k < 4; ++k) { const int p = tid + 512 * k, q = p >> 4, c8 = p & 15;
                        *(LAS v4u*)(Vl + q * VPI + 16 * c8) = *(const v4u*)(P + (size_t)(r0 + q) * NP + C_SGV + g * 128 + 8 * c8); }
                    __syncthreads();
                    f32x16 acc[2];
#pragma unroll
                    for (int t = 0; t < 2; ++t)
#pragma unroll
                        for (int i = 0; i < 16; ++i) acc[t][i] = 0.f;
                    const int i16 = lane & 15, qq = i16 >> 2, pp = i16 & 3, gb = (lane >> 4) & 1;
                    const unsigned tra = (unsigned)(size_t)Vl + (unsigned)((8 * hh + qq) * VPI + 2 * (32 * ct0 + 16 * gb + 4 * pp));
#pragma unroll
                    for (int ks = 0; ks < 8; ++ks) {
                        const bf16x8 af = *(const LAS bf16x8*)(Wl + (32 * pt + r31) * WPI + 2 * (16 * ks + 8 * hh));
                        v2u t0, t1, t2, t3;
                        asm volatile("ds_read_b64_tr_b16 %0, %4 offset:%5\n\tds_read_b64_tr_b16 %1, %4 offset:%6\n\tds_read_b64_tr_b16 %2, %4 offset:%7\n\tds_read_b64_tr_b16 %3, %4 offset:%8\n\ts_waitcnt lgkmcnt(0)"
                                     : "=&v"(t0), "=&v"(t1), "=&v"(t2), "=&v"(t3)
                                     : "v"(tra), "n"(16 * ks * VPI), "n"((16 * ks + 4) * VPI), "n"(16 * ks * VPI + 64), "n"((16 * ks + 4) * VPI + 64) : "memory");
                        acc[0] = MFMA32(af, __builtin_bit_cast(bf16x8, (v4u){t0.x, t0.y, t1.x, t1.y}), acc[0]);
                        acc[1] = MFMA32(af, __builtin_bit_cast(bf16x8, (v4u){t2.x, t2.y, t3.x, t3.y}), acc[1]);
                    }
                    const float* sb = args.in[I_SGB] + ((size_t)l * 8 + g) * 128 + 32 * pt + 4 * hh;
                    f32x4 b4v[4]; unsigned uu[16];
#pragma unroll
                    for (int g4 = 0; g4 < 4; ++g4) { b4v[g4] = *(const f32x4*)(sb + 8 * g4);
#pragma unroll
                        for (int e = 0; e < 4; ++e) { const size_t row = (size_t)(r0 + 32 * pt + 8 * g4 + 4 * hh + e); const bf16* up = P + row * NP + C_SGU + g * 128 + 32 * ct0 + r31;
                            uu[4 * g4 + e] = (unsigned)up[0] | ((unsigned)up[32] << 16); } }
#pragma unroll
                    for (int g4 = 0; g4 < 4; ++g4)
#pragma unroll
                        for (int e = 0; e < 4; ++e) { const size_t row = (size_t)(r0 + 32 * pt + 8 * g4 + 4 * hh + e); unsigned char* yp = (unsigned char*)Y3 + row * D + g * 128 + 32 * ct0 + r31;
                            yp[0] = (unsigned char)f2fp8(bflo(uu[4 * g4 + e]) * (acc[0][4 * g4 + e] + b4v[g4][e])); yp[32] = (unsigned char)f2fp8(bfhi(uu[4 * g4 + e]) * (acc[1][4 * g4 + e] + b4v[g4][e])); }
                }
            }
        }
        SEAM(pb + 3);
        if (EN(6) && IN(pb + 4)) for (int rep_ = 0; rep_ < NREP(6); ++rep_) { HIDE_TID;
            for (int r = gw; r < ML; r += NGW) {
                float a[16], bq[16], g[16];
                ld16(ODN + (size_t)r * D + 16 * lane, a); ld16(ODN + ((size_t)MT + r) * D + 16 * lane, bq); ld16(P + (size_t)r * NP + C_DNG + 16 * lane, g);
                float ss = 0.f;
#pragma unroll
                for (int i = 0; i < 16; ++i) { a[i] += bq[i]; ss += a[i] * a[i]; }
                ss += __shfl_xor(ss, 1); ss += __shfl_xor(ss, 2); ss += __shfl_xor(ss, 4);
                const float rinv = rsqrtf(ss * (1.f / 128.f) + EPS);
                const float* ng = args.in[I_DNNG] + l * 128 + 16 * (lane & 7);
#pragma unroll
                for (int i = 0; i < 16; ++i) a[i] = a[i] * rinv * ng[i] * siluf_(g[i]);
                { v4u w;
                  w.x = __builtin_amdgcn_cvt_pk_fp8_f32(a[0], a[1], 0, false); w.x = __builtin_amdgcn_cvt_pk_fp8_f32(a[2], a[3], w.x, true); w.y = __builtin_amdgcn_cvt_pk_fp8_f32(a[4], a[5], 0, false); w.y = __builtin_amdgcn_cvt_pk_fp8_f32(a[6], a[7], w.y, true);
                  w.z = __builtin_amdgcn_cvt_pk_fp8_f32(a[8], a[9], 0, false); w.z = __builtin_amdgcn_cvt_pk_fp8_f32(a[10], a[11], w.z, true); w.w = __builtin_amdgcn_cvt_pk_fp8_f32(a[12], a[13], 0, false); w.w = __builtin_amdgcn_cvt_pk_fp8_f32(a[14], a[15], w.w, true);
                  *(v4u*)((unsigned char*)Y3 + (size_t)MT * D + (size_t)r * D + 16 * lane) = w; }
            }
        }
        SEAM(pb + 4);
        if (EN(7) && IN(pb + 5)) for (int rep_ = 0; rep_ < NREP(7); ++rep_) { HIDE_TID;
            pg8::OrderMerge S; S.A = (const char*)Y3; S.Bt = (const char*)(ws + WS_WPROJ8) + (size_t)l * 3 * 1024 * 1024; S.nM = ML / 256; S.nN = 4; S.G = G; S.c = bx;
            S.a_stride = (size_t)MT * D; S.b_stride = (size_t)1024 * 1024; S.tile = (size_t)256 * 1024;
            pg8::EpiMerge E{P + C_GATE, MB};
            pg8::gemm_phase<pg8::EpiMerge, pg8::OrderMerge, false, true>(lds, S, E, wave);
            { const int cv_rem = (ML / 256 * 4) % G, cv_short = cv_rem ? G - cv_rem : 0, cv_n1 = CV_N_TOT - (CV_E_QUOTA + CV_F_QUOTA) * 8 * cv_short;
              if (cv_rem && bx >= cv_rem) { LAS float* scr = (LAS float*)(lds + wave * 4096);
                  for (int k = 0; k < CV_E_QUOTA; ++k) expert_item(cv_n1 + ((bx - cv_rem) * 8 + wave) + k * (cv_short * 8), l, args.in[I_WGU], args.in[I_WDN], WTGU, WTDN, scr, lane); } }
        }
        SEAM(pb + 5);
        if (EN(8) && IN(pb + 6)) for (int rep_ = 0; rep_ < NREP(8); ++rep_) { HIDE_TID;
            pg8::OrderRect2 S; S.A = (const char*)MB; S.Bt = (const char*)(ws + WS_WOUT8) + (size_t)l * 1024 * 1024; S.G = G; S.c = bx; S.tile = (size_t)256 * 1024; S.pn0 = 0;
            S.nM0 = ML / 256; S.nN0 = 4; S.nM1 = 0; S.nN1 = 0;
            pg8::EpiStoreBf16 E{(bf16*)MF, 1024, 1.0f};
            pg8::gemm_phase<pg8::EpiStoreBf16, pg8::OrderRect2, false, true>(lds, S, E, wave);
            { const int cv_rem = (ML / 256 * 4) % G, cv_short = cv_rem ? G - cv_rem : 0, cv_n1 = CV_N_TOT - (CV_E_QUOTA + CV_F_QUOTA) * 8 * cv_short;
              if (cv_rem && bx >= cv_rem) { LAS float* scr = (LAS float*)(lds + wave * 4096);
                  for (int k = 0; k < CV_F_QUOTA; ++k) expert_item(cv_n1 + CV_E_QUOTA * 8 * cv_short + ((bx - cv_rem) * 8 + wave) + k * (cv_short * 8), l, args.in[I_WGU], args.in[I_WDN], WTGU, WTDN, scr, lane); } }
        }
        SEAM(pb + 6);
        const int RPB = (ML + G - 1) / G;
        if (EN(9) && IN(pb + 7)) for (int rep_ = 0; rep_ < NREP(9); ++rep_) { HIDE_TID;
            LAS float* rwT = (LAS float*)lds;
            LAS float* lg = (LAS float*)(lds + MISC_OFF + 1024) + wave * 32;
            LAS unsigned* hist = (LAS unsigned*)(lds + MISC_OFF + 512);
            const float* rw = args.in[I_RW] + (size_t)l * 1024 * 32;
            for (int i = tid; i < 32768; i += 512) { const int d = i >> 5, e = i & 31; rwT[e * 1024 + (d ^ ((e & 7) << 2))] = rw[i]; }
            if (tid < 32) hist[tid] = 0u;
            __syncthreads();
            const int rbeg = bx * RPB, rend = (rbeg + RPB) < ML ? (rbeg + RPB) : ML;
            f32x4 on[4], xn[4];
#define G_LOAD(rr) do { const int r_ = (rr) < rend ? (rr) : rend - 1; const float* xr_ = l == 0 ? (r_ < NL ? args.in[I_X] + (size_t)r_ * D : args.in[I_CTX] + (size_t)(r_ - NL) * D) : X + (size_t)r_ * D; const bf16* or_ = (const bf16*)MF + (size_t)r_ * D; \
                _Pragma("unroll") for (int j = 0; j < 4; ++j) { const v2u ow_ = ((const v2u*)or_)[64 * j + lane]; on[j] = (f32x4){bflo(ow_.x), bfhi(ow_.x), bflo(ow_.y), bfhi(ow_.y)}; xn[j] = ((const f32x4*)xr_)[64 * j + lane]; } } while (0)
            f32x4 npv[4], nfv[4];
#pragma unroll
            for (int j = 0; j < 4; ++j) { npv[j] = ((const f32x4*)(args.in[I_NPOST] + l * D))[64 * j + lane]; nfv[j] = ((const f32x4*)(args.in[I_NPREF] + l * D))[64 * j + lane]; }
            if (rbeg + wave < rend) G_LOAD(rbeg + wave);
            for (int r = rbeg + wave; r < rend; r += 8) {
                const float* md = MODL + (size_t)mod_slot(r) * 6144;
                f32x4 g1v[4], sh2v[4], sc2v[4];
#pragma unroll
                for (int j = 0; j < 4; ++j) { g1v[j] = ((const f32x4*)(md + 2048))[64 * j + lane]; sh2v[j] = ((const f32x4*)(md + 3072))[64 * j + lane]; sc2v[j] = ((const f32x4*)(md + 4096))[64 * j + lane]; }
                f32x4 o[4], x[4]; float s = 0.f;
#pragma unroll
                for (int j = 0; j < 4; ++j) { o[j] = on[j]; x[j] = xn[j]; s += (o[j].x * o[j].x + o[j].y * o[j].y) + (o[j].z * o[j].z + o[j].w * o[j].w); }
                asm volatile("" ::: "memory");
                G_LOAD(r + 8);
                asm volatile("" ::: "memory");
                const float rinv = rsqrtf(wave_sum(s) * (1.f / D) * (1.0f / 4096.0f) + EPS) * (1.0f / 64.0f); float s2 = 0.f;
#pragma unroll
                for (int j = 0; j < 4; ++j) { const f32x4 np = npv[j], g1 = g1v[j];
                    x[j] = x[j] + g1 * (o[j] * rinv * np); ((f32x4*)(X + (size_t)r * D))[64 * j + lane] = x[j];
                    s2 += (x[j].x * x[j].x + x[j].y * x[j].y) + (x[j].z * x[j].z + x[j].w * x[j].w); }
                const float rinv2 = rsqrtf(wave_sum(s2) * (1.f / D) + EPS);
                f32x4 h[4];
#pragma unroll
                for (int j = 0; j < 4; ++j) { const f32x4 nf = nfv[j], sh2 = sh2v[j], sc2 = sc2v[j];
                    h[j] = x[j] * rinv2 * nf * (sc2 + 1.0f) + sh2;
                    unsigned ob = __builtin_amdgcn_cvt_pk_fp8_f32(h[j].x, h[j].y, 0, false); ob = __builtin_amdgcn_cvt_pk_fp8_f32(h[j].z, h[j].w, ob, true);
                    ((unsigned*)((unsigned char*)H + (size_t)r * 1024))[64 * j + lane] = ob; }
                float lgt[32];
#pragma unroll
                for (int e = 0; e < 32; ++e) { float a0 = 0.f, a1 = 0.f;
#pragma unroll
                    for (int j = 0; j < 4; ++j) { const f32x4 w4 = *(const LAS f32x4*)(rwT + e * 1024 + ((4 * lane + 256 * j) ^ ((e & 7) << 2)));
                        a0 = fmaf(h[j].x, w4.x, a0); a1 = fmaf(h[j].y, w4.y, a1); a0 = fmaf(h[j].z, w4.z, a0); a1 = fmaf(h[j].w, w4.w, a1); }
                    lgt[e] = a0 + a1; }
                float r16[16], r8[8], r4[4], r2[2], r1;
                { const bool up = (lane & 32) != 0;
#pragma unroll
                  for (int i = 0; i < 16; ++i) { const float keep = up ? lgt[16 + i] : lgt[i], send = up ? lgt[i] : lgt[16 + i]; r16[i] = keep + __shfl_xor(send, 32); } }
                { const bool up = (lane & 16) != 0;
#pragma unroll
                  for (int i = 0; i < 8; ++i) { const float keep = up ? r16[8 + i] : r16[i], send = up ? r16[i] : r16[8 + i]; r8[i] = keep + __shfl_xor(send, 16); } }
                { const bool up = (lane & 8) != 0;
#pragma unroll
                  for (int i = 0; i < 4; ++i) { const float keep = up ? r8[4 + i] : r8[i], send = up ? r8[i] : r8[4 + i]; r4[i] = keep + __shfl_xor(send, 8); } }
                { const bool up = (lane & 4) != 0;
#pragma unroll
                  for (int i = 0; i < 2; ++i) { const float keep = up ? r4[2 + i] : r4[i], send = up ? r4[i] : r4[2 + i]; r2[i] = keep + __shfl_xor(send, 4); } }
                { const bool up = (lane & 2) != 0; const float keep = up ? r2[1] : r2[0], send = up ? r2[0] : r2[1]; r1 = keep + __shfl_xor(send, 2); }
                r1 += __shfl_xor(r1, 1);
                const int eo = lane >> 1;
                float val = r1 + args.in[I_RB][l * 32 + eo];
                float tv[4]; int ti[4];
#pragma unroll
                for (int k = 0; k < 4; ++k) { const float mxv = wave_max(val); const unsigned long long bal = __ballot(val == mxv);
                    const int bi = (__ffsll((long long)bal) - 1) >> 1; tv[k] = mxv; ti[k] = bi; if (eo == bi) val = -INFINITY; }
                if (lane < 4) {
                    const float e1 = fexp(tv[1] - tv[0]), e2 = fexp(tv[2] - tv[0]), e3 = fexp(tv[3] - tv[0]); const float inv = frcp(1.0f + e1 + e2 + e3);
                    const float gsel = lane == 0 ? inv : (lane == 1 ? e1 * inv : (lane == 2 ? e2 * inv : e3 * inv));
                    const int isel = lane == 0 ? ti[0] : (lane == 1 ? ti[1] : (lane == 2 ? ti[2] : ti[3]));
                    TOPI[(size_t)r * 4 + lane] = isel; GATE[(size_t)r * 4 + lane] = gsel;
                    atomicAdd((unsigned*)&hist[isel], 1u);
                }
            }
#undef G_LOAD
            __syncthreads();
            if (tid < 32) CNT[(size_t)bx * 32 + tid] = hist[tid];
        }
        SEAM(pb + 7);
        if (EN(10) && IN(pb + 8)) for (int rep_ = 0; rep_ < NREP(10); ++rep_) { HIDE_TID;
            LAS unsigned* red = (LAS unsigned*)lds;
            LAS unsigned* base = (LAS unsigned*)(lds + 8192);
            LAS unsigned* cur = (LAS unsigned*)(lds + 8192 + 256);
            { const int e = tid & 31, part = tid >> 5; unsigned tot = 0u, pre = 0u;
              for (int b2 = part; b2 < G; b2 += 16) { const unsigned c = CNT[(size_t)b2 * 32 + e]; tot += c; pre += (b2 < bx) ? c : 0u; }
              red[part * 64 + e] = tot; red[part * 64 + 32 + e] = pre; }
            __syncthreads();
            if (tid < 32) { unsigned tot = 0u, pre = 0u;
#pragma unroll
                for (int p = 0; p < 16; ++p) { tot += red[p * 64 + tid]; pre += red[p * 64 + 32 + tid]; }
                red[1024 + tid] = tot; red[1024 + 32 + tid] = pre; cur[tid] = 0u; }
            __syncthreads();
            if (tid == 0) { unsigned off = 0u;
                for (int e = 0; e < 32; ++e) { const unsigned tot = red[1024 + e], np = (tot + 255u) >> 8; base[e] = off + red[1024 + 32 + e]; red[1024 + 64 + e] = off;
                    if (bx == 0) for (unsigned p = 0; p < np; ++p) MOEI[64 + (off >> 8) + p] = (unsigned)e;
                    off += np << 8; }
                if (bx == 0) MOEI[0] = off >> 8; }
            __syncthreads();
            if (bx == 0) {
                for (int e = 0; e < 32; ++e) { const unsigned tot = red[1024 + e], beg = red[1024 + 64 + e] + tot, end = red[1024 + 64 + e] + (((tot + 255u) >> 8) << 8);
                    for (unsigned p = beg + tid; p < end; p += 512) ROWMAP[p] = 0; } }
            const int rbeg = bx * RPB, rend = (rbeg + RPB) < ML ? (rbeg + RPB) : ML;
            for (int idx = tid; idx < (rend - rbeg) * 4; idx += 512) { const int r = rbeg + (idx >> 2);
                const int e = TOPI[(size_t)r * 4 + (idx & 3)]; const int pos = (int)(base[e] + atomicAdd((unsigned*)&cur[e], 1u));
                SLOT[(size_t)r * 4 + (idx & 3)] = pos; ROWMAP[pos] = r; }
        }
        SEAM(pb + 8);
        if (EN(11) && IN(pb + 9)) for (int rep_ = 0; rep_ < NREP(11); ++rep_) { HIDE_TID;
            pg8::OrderMoeG S; S.A = (const char*)H; S.Bt = (const char*)WTGU + (size_t)l * 32 * 2048 * 1024; S.nP = (int)__builtin_amdgcn_readfirstlane(MOEI[0]); S.nN = 8; S.G = G; S.c = bx;
            S.e_stride = (size_t)2048 * 1024; S.b_tile = (size_t)256 * 1024; S.p2e = MOEI + 64; S.rowmap = ROWMAP;
            pg8::EpiSwiglu E{ACT, args.in[I_BGU] + (size_t)l * 32 * 2048, 1.0f / 64.0f};
            pg8::gemm_phase<pg8::EpiSwiglu, pg8::OrderMoeG, true, true>(lds, S, E, wave);
        }
        SEAM(pb + 9);
        if (EN(12) && IN(pb + 10)) for (int rep_ = 0; rep_ < NREP(12); ++rep_) { HIDE_TID;
            pg8::OrderMoe S; S.A = (const char*)ACT; S.Bt = (const char*)WTDN + (size_t)l * 32 * 1024 * 1024; S.nP = (int)__builtin_amdgcn_readfirstlane(MOEI[0]); S.nN = 4; S.G = G; S.c = bx;
            S.e_stride = (size_t)1024 * 1024; S.tile = (size_t)256 * 1024; S.p2e = MOEI + 64;
            pg8::EpiDown E{YS, args.in[I_BDN] + (size_t)l * 32 * 1024, 1.0f / 64.0f};
            pg8::gemm_phase<pg8::EpiDown, pg8::OrderMoe, false, true>(lds, S, E, wave);
        }
        SEAM(pb + 10);
        if (EN(13) && IN(pb + 11)) for (int rep_ = 0; rep_ < NREP(13); ++rep_) { HIDE_TID;
            int slB = 0; float gtB = 0.f; v2u ywA[4][4], ywB[4][4]; f32x4 xwA[4], xwB[4]; float gkA[4], gkB[4];
#define K_SLOT(rr, sl_, gt_) do { sl_ = 0; gt_ = 0.f; if ((rr) < ML && lane < 4) { sl_ = SLOT[(size_t)(rr) * 4 + lane]; gt_ = GATE[(size_t)(rr) * 4 + lane]; } } while (0)
#define K_ROWS(rr, sl_, gt_, yw_, xw_, gk_) do { const int r_ = (rr) < ML ? (rr) : ML - 1; _Pragma("unroll") for (int k = 0; k < 4; ++k) { const int sk = __shfl(sl_, k); gk_[k] = __shfl(gt_, k); \
                _Pragma("unroll") for (int j = 0; j < 4; ++j) yw_[k][j] = ((const v2u*)(YS + (size_t)sk * D))[64 * j + lane]; } \
                _Pragma("unroll") for (int j = 0; j < 4; ++j) xw_[j] = ((const f32x4*)(X + (size_t)r_ * D))[64 * j + lane]; } while (0)
            f32x4 nfK[4], ggK[4];
#pragma unroll
            for (int j = 0; j < 4; ++j) { nfK[j] = ((const f32x4*)(args.in[I_NPOSTF] + l * D))[64 * j + lane]; ggK[j] = ((const f32x4*)(args.in[I_NPRE] + D))[64 * j + lane]; }
            const int RWK = (ML + NGW - 1) / NGW, k0r = gw * RWK, k1r = (k0r + RWK) < ML ? (k0r + RWK) : ML;
            f32x4 g2K[4], shK[4], scK[4]; int curslotK = -1;
#pragma unroll
            for (int j = 0; j < 4; ++j) { g2K[j] = (f32x4){0.f, 0.f, 0.f, 0.f}; shK[j] = g2K[j]; scK[j] = g2K[j]; }
            { int sl0; float gt0; K_SLOT(k0r, sl0, gt0); K_ROWS(k0r, sl0, gt0, ywA, xwA, gkA); K_SLOT(k0r + 1, slB, gtB); }
            for (int r = k0r; r < k1r; ++r) {
                if (mod_slot(r) != curslotK) { curslotK = mod_slot(r); const float* md = MODL + (size_t)curslotK * 6144; const float* md1 = MOD + (size_t)(9 + curslotK) * 6144;
#pragma unroll
                    for (int j = 0; j < 4; ++j) { g2K[j] = ((const f32x4*)(md + 5120))[64 * j + lane]; if (l == 0) { shK[j] = ((const f32x4*)md1)[64 * j + lane]; scK[j] = ((const f32x4*)(md1 + 1024))[64 * j + lane]; } } }
                asm volatile("" ::: "memory");
                K_ROWS(r + 1, slB, gtB, ywB, xwB, gkB);
                K_SLOT(r + 2, slB, gtB);
                asm volatile("" ::: "memory");
                f32x4 y[4];
#pragma unroll
                for (int j = 0; j < 4; ++j) y[j] = (f32x4){0.f, 0.f, 0.f, 0.f};
#pragma unroll
                for (int k = 0; k < 4; ++k) { const float gk = gkA[k];
#pragma unroll
                    for (int j = 0; j < 4; ++j) { const v2u w = ywA[k][j];
                        y[j].x += gk * bflo(w.x); y[j].y += gk * bfhi(w.x); y[j].z += gk * bflo(w.y); y[j].w += gk * bfhi(w.y); } }
                float s = 0.f;
#pragma unroll
                for (int j = 0; j < 4; ++j) s += (y[j].x * y[j].x + y[j].y * y[j].y) + (y[j].z * y[j].z + y[j].w * y[j].w);
                const float rinv = rsqrtf(wave_sum(s) * (1.f / D) + EPS);
                f32x4 x[4];
#pragma unroll
                for (int j = 0; j < 4; ++j) { const f32x4 nf = nfK[j], g2 = g2K[j];
                    x[j] = xwA[j] + g2 * (y[j] * rinv * nf); }
                if (l == 0) {
#pragma unroll
                    for (int j = 0; j < 4; ++j) ((f32x4*)(X + (size_t)r * D))[64 * j + lane] = x[j];
                    float s2 = 0.f;
#pragma unroll
                    for (int j = 0; j < 4; ++j) s2 += (x[j].x * x[j].x + x[j].y * x[j].y) + (x[j].z * x[j].z + x[j].w * x[j].w);
                    const float rinv2 = rsqrtf(wave_sum(s2) * (1.f / D) + EPS);
#pragma unroll
                    for (int j = 0; j < 4; ++j) { const f32x4 gg = ggK[j], sh = shK[j], sc = scK[j];
                        const f32x4 hh = x[j] * rinv2 * gg * (sc + 1.0f) + sh;
                        v2u ob; ob.x = pk2(hh.x, hh.y); ob.y = pk2(hh.z, hh.w); ((v2u*)(H + (size_t)r * D))[64 * j + lane] = ob;
                        unsigned o8 = __builtin_amdgcn_cvt_pk_fp8_f32(hh.x, hh.y, 0, false); o8 = __builtin_amdgcn_cvt_pk_fp8_f32(hh.z, hh.w, o8, true); ((unsigned*)(ws + WS_H8 + (size_t)r * 1024))[64 * j + lane] = o8; }
                } else {
#pragma unroll
                    for (int j = 0; j < 4; ++j) ((f32x4*)(args.out + (size_t)r * D))[64 * j + lane] = x[j];
                }
#pragma unroll
                for (int k = 0; k < 4; ++k) { gkA[k] = gkB[k];
#pragma unroll
                    for (int j = 0; j < 4; ++j) ywA[k][j] = ywB[k][j]; }
#pragma unroll
                for (int j = 0; j < 4; ++j) xwA[j] = xwB[j];
            }
#undef K_SLOT
#undef K_ROWS
        }
        SEAM(pb + 11);
    }
}

__global__ void __launch_bounds__(512, 2) mk_fwd(Args args) {
    extern __shared__ __attribute__((aligned(16))) unsigned char lds_raw[];
    LAS unsigned char* lds = (LAS unsigned char*)lds_raw;
    const int tid0 = threadIdx.x;
    KCtx K;
    K.lds = lds; K.ws = args.ws; K.out = args.out;
#pragma unroll
    for (int i = 0; i < 30; ++i) K.in[i] = args.in[i];
    K.tid0 = tid0; K.wave = __builtin_amdgcn_readfirstlane(tid0 >> 6); K.G = gridDim.x; K.bx = blockIdx.x; K.gw = K.bx * 8 + K.wave; K.NGW = K.G * 8; K.lo = args.ph_lo; K.hi = args.ph_hi;
    volatile LAS unsigned* MISC = (volatile LAS unsigned*)(lds + MISC_OFF);
    { const int wave = K.wave; HIDE_TID; for (int u = tid; u < (LDS_BYTES - MISC_OFF) / 4; u += 512) ((LAS unsigned*)(lds + MISC_OFF))[u] = 0u; }
    __syncthreads();
    unsigned* ctl = (unsigned*)(args.ws + WS_CTL);
    const XcdBarrier bar = xcd_barrier_post(ctl + CW_BAR, MISC + 8);
    prologue_body(K, bar);
    layer_body<0>(K, bar);
    layer_body<1>(K, bar);
}

constexpr int N_PHASES = 26;
extern "C" void kernel_launch(void* const* d_in, const int* in_sizes, int n_in, void* d_out, int out_size, void* d_ws, size_t ws_size, hipStream_t stream) {
    static int grid = 0;
    if (grid == 0) {
        if (n_in != 30 || ws_size < WS_END) { fprintf(stderr, "kernel_launch: need 30 inputs and %zu bytes of workspace (got %d, %zu)\n", (size_t)WS_END, n_in, ws_size); grid = -1; return; }
        int dev = 0, cus = 0, per_cu = 0;
        if (hipGetDevice(&dev) != hipSuccess || hipDeviceGetAttribute(&cus, hipDeviceAttributeMultiprocessorCount, dev) != hipSuccess) { grid = -1; return; }
        if (hipFuncSetAttribute((const void*)mk_fwd, hipFuncAttributeMaxDynamicSharedMemorySize, LDS_BYTES) != hipSuccess) { fprintf(stderr, "kernel_launch: hipFuncSetAttribute failed\n"); grid = -1; return; }
        if (hipOccupancyMaxActiveBlocksPerMultiprocessor(&per_cu, (const void*)mk_fwd, 512, LDS_BYTES) != hipSuccess || per_cu < 1)
            fprintf(stderr, "kernel_launch: occupancy query reports %d workgroups per CU\n", per_cu);
        (void)hipGetLastError();
        grid = cus;
    }
    if (grid < 0) return;
    if (hipMemsetAsync((char*)d_ws + WS_CTL, 0, CTL_ZERO_BYTES, stream) != hipSuccess) return;
    Args a{};
    for (int i = 0; i < 30; ++i) a.in[i] = (const float*)d_in[i];
    a.out = (float*)d_out; a.ws = (unsigned char*)d_ws; a.ph_lo = 0; a.ph_hi = N_PHASES;
    hipLaunchKernelGGL(mk_fwd, dim3(grid), dim3(512), LDS_BYTES, stream, a);
}
```
